# Optimizing an MI355X kernel written in HIP

```python
import math
import jax, jax.numpy as jnp
from jax import lax
import numpy as np

D_MODEL = 1024
BATCH = 1
SEQ = 16384
DEPTH = 1
DEC_BATCH = 8
DEC_SEQ = 4096
PAST_LEN = 128

HEAD_DIM = 64
N_HEADS = D_MODEL // HEAD_DIM
N_KV_HEADS = N_HEADS // 4
GQA_GROUP = N_HEADS // N_KV_HEADS
ATTN_WIDTH = N_HEADS * HEAD_DIM
KV_WIDTH = N_KV_HEADS * HEAD_DIM
CONV_WIDTH = D_MODEL
CONV_K = 3
GRID_W = 64
Q_BLOCK = 128
ROPE_THETA = 10000.0
ROPE_HALF = HEAD_DIM // 2
NORM_EPS = 1e-6
LN_EPS = 1e-5
DN_ALPHA = (2.0 * DEPTH) ** 0.25
DN_BETA = (8.0 * DEPTH) ** -0.25
SPLIT_SIZES = (ATTN_WIDTH, KV_WIDTH, KV_WIDTH, ATTN_WIDTH,
               CONV_WIDTH, CONV_WIDTH, CONV_WIDTH, CONV_WIDTH,
               D_MODEL, D_MODEL)
SPLIT_POINTS = tuple(int(v) for v in np.cumsum(SPLIT_SIZES)[:-1])
IN_WIDTH = int(sum(SPLIT_SIZES))

kernel_name = "hybrid_gqa_axialrope_shortconv_gated_deepnorm"


def _rms_norm(x, g):
    xf = x.astype(jnp.float32)
    xf = xf * lax.rsqrt(jnp.mean(xf * xf, axis=-1, keepdims=True) + NORM_EPS)
    return xf.astype(x.dtype) * g


def _layer_norm(x, g, b):
    xf = x.astype(jnp.float32)
    mu = jnp.mean(xf, axis=-1, keepdims=True)
    var = jnp.mean(jnp.square(xf - mu), axis=-1, keepdims=True)
    return ((xf - mu) * lax.rsqrt(var + LN_EPS)).astype(x.dtype) * g + b


def _rotate(u, cos, sin):
    m = u.shape[-1] // 2
    u1, u2 = u[..., :m], u[..., m:]
    return jnp.concatenate([u1 * cos - u2 * sin, u2 * cos + u1 * sin], axis=-1)


def _axial_tables(seq_len, dtype):
    rows = seq_len // GRID_W
    row = jnp.repeat(jnp.arange(rows, dtype=jnp.float32), GRID_W)
    col = jnp.tile(jnp.arange(GRID_W, dtype=jnp.float32), rows)
    inv_freq = ROPE_THETA ** (-jnp.arange(0, ROPE_HALF, 2, dtype=jnp.float32) / ROPE_HALF)
    ang_r = row[:, None, None] * inv_freq
    ang_c = col[:, None, None] * inv_freq
    return (jnp.cos(ang_r).astype(dtype), jnp.sin(ang_r).astype(dtype),
            jnp.cos(ang_c).astype(dtype), jnp.sin(ang_c).astype(dtype))


def _axial_rope(x, tabs):
    cr, sr, cc, sc = tabs
    return jnp.concatenate([_rotate(x[..., :ROPE_HALF], cr, sr),
                            _rotate(x[..., ROPE_HALF:], cc, sc)], axis=-1)


def _gqa_attention(q, k, v):
    B, S = q.shape[0], q.shape[1]
    nblk = S // Q_BLOCK
    scale = 1.0 / math.sqrt(HEAD_DIM)
    qb = q.reshape(B, nblk, Q_BLOCK, N_KV_HEADS, GQA_GROUP, HEAD_DIM).transpose(1, 0, 2, 3, 4, 5)

    def block(qi):
        s = jnp.einsum('bqkgd,bskd->bkgqs', qi, k).astype(jnp.float32) * scale
        p = jax.nn.softmax(s, axis=-1).astype(v.dtype)
        return jnp.einsum('bkgqs,bskd->bqkgd', p, v)

    o = lax.map(block, qb)
    return o.transpose(1, 0, 2, 3, 4, 5).reshape(B, S, ATTN_WIDTH)


def _short_conv(u, w, b):
    up = jnp.pad(u, ((0, 0), (1, 1), (0, 0)))
    return up[:, :-2] * w[0] + up[:, 1:-1] * w[1] + up[:, 2:] * w[2] + b


def _layer(x, w_in, b_in, q_gain, k_gain, conv_w, conv_b,
           w_attn_out, w_conv_out, w_o, ln_g, ln_b):
    B, S, _ = x.shape
    proj = jnp.einsum('bsd,df->bsf', x, w_in) + b_in
    q, k, v, z_a, gb, gc, h, z_c, g_a, g_c = jnp.split(proj, SPLIT_POINTS, axis=-1)

    tabs = _axial_tables(S, x.dtype)
    q = _axial_rope(_rms_norm(q.reshape(B, S, N_HEADS, HEAD_DIM), q_gain), tabs)
    k = _axial_rope(_rms_norm(k.reshape(B, S, N_KV_HEADS, HEAD_DIM), k_gain), tabs)
    v = v.reshape(B, S, N_KV_HEADS, HEAD_DIM)
    attn = _gqa_attention(q, k, v) * jax.nn.silu(z_a)
    a_out = jnp.einsum('bsf,fd->bsd', attn, w_attn_out)

    conv = gb * _short_conv(gc * h, conv_w, conv_b) * jax.nn.silu(z_c)
    c_out = jnp.einsum('bsf,fd->bsd', conv, w_conv_out)

    merged = jax.nn.sigmoid(g_a) * a_out + jax.nn.sigmoid(g_c) * c_out
    out = jnp.einsum('bsd,de->bse', merged, w_o)
    return _layer_norm(DN_ALPHA * x + out, ln_g, ln_b)


def setup_inputs(seed: int = 0) -> dict:
    key = jax.random.key(seed)
    ks = jax.random.split(key, 14)
    f32 = jnp.float32
    nrm = lambda k, shp: jax.random.normal(k, shp, dtype=f32)
    return {
        "x_prompt": nrm(ks[0], (BATCH, SEQ, D_MODEL)),
        "x_sample": nrm(ks[1], (DEC_BATCH, DEC_SEQ, D_MODEL)),
        "w_in": nrm(ks[2], (DEPTH, D_MODEL, IN_WIDTH)) * D_MODEL ** -0.5,
        "b_in": nrm(ks[3], (DEPTH, IN_WIDTH)) * 0.01,
        "q_gain": 1.0 + 0.02 * nrm(ks[4], (DEPTH, HEAD_DIM)),
        "k_gain": 1.0 + 0.02 * nrm(ks[5], (DEPTH, HEAD_DIM)),
        "conv_w": nrm(ks[6], (DEPTH, CONV_K, CONV_WIDTH)) * CONV_K ** -0.5,
        "conv_b": nrm(ks[7], (DEPTH, CONV_WIDTH)) * 0.01,
        "w_attn_out": nrm(ks[8], (DEPTH, ATTN_WIDTH, D_MODEL)) * ATTN_WIDTH ** -0.5 * DN_BETA,
        "w_conv_out": nrm(ks[9], (DEPTH, CONV_WIDTH, D_MODEL)) * CONV_WIDTH ** -0.5 * DN_BETA,
        "w_o": nrm(ks[10], (DEPTH, D_MODEL, D_MODEL)) * D_MODEL ** -0.5 * DN_BETA,
        "ln_g": 1.0 + 0.02 * nrm(ks[11], (DEPTH, D_MODEL)),
        "ln_b": 0.01 * nrm(ks[12], (DEPTH, D_MODEL)),
    }


def reference(x_prompt, x_sample, w_in, b_in, q_gain, k_gain, conv_w, conv_b,
              w_attn_out, w_conv_out, w_o, ln_g, ln_b):
    y_prompt = x_prompt
    y_sample = x_sample
    for l in range(DEPTH):
        p = (w_in[l], b_in[l], q_gain[l], k_gain[l], conv_w[l], conv_b[l],
             w_attn_out[l], w_conv_out[l], w_o[l], ln_g[l], ln_b[l])
        y_prompt = _layer(y_prompt, *p)
        y_sample = _layer(y_sample, *p)
    return (y_prompt, y_sample)
```

```cpp
#include <hip/hip_runtime.h>
#include <hip/hip_cooperative_groups.h>
#include <cstdio>
#include <cstdint>
namespace cg = cooperative_groups;

#ifndef ATT_C
#define ATT_C 1.0f
#endif
#ifndef OSC
#define OSC 1.0f
#endif
#ifndef MK_SINGLE
#define MK_SINGLE 1
#endif

typedef unsigned short bf16_t;
typedef short bf16x8 __attribute__((ext_vector_type(8)));
typedef float f32x16 __attribute__((ext_vector_type(16)));
typedef float f32x4 __attribute__((ext_vector_type(4)));
typedef float f32x2 __attribute__((ext_vector_type(2)));
typedef unsigned u32x4 __attribute__((ext_vector_type(4)));
typedef __bf16 bf16x2_t __attribute__((ext_vector_type(2)));
#define DI __device__ __forceinline__
DI int opq_v(int t) { asm volatile("" : "+v"(t)); return t; }
DI int opq_s(int t) { asm volatile("" : "+s"(t)); return t; }
#define TID (opq_v((int)threadIdx.x))
#define BID (opq_s((int)blockIdx.x))

constexpr int D = 1024, INW = 8704, T_ALL = 49152, CHMAX = 32768;
constexpr int BK = 64, LROW = BK + 8, WT = 256 * LROW, XT = 256 * LROW, GBUF = WT + XT;
constexpr int AROW = 72, ATILE = 64 * AROW;
constexpr int SROWE = 72, STG = 32 * SROWE;
constexpr int LDS_ELEMS = (GBUF > 4 * ATILE ? GBUF : 4 * ATILE) + 8 * STG;
constexpr float QSCALE = 0.125f * 1.4426950408889634f;
constexpr float DN_ALPHA = 1.189207115002721f;
constexpr int NPHASE = 10;
constexpr int NTHR = 512;
constexpr int PX = 1088;

struct Params {
  const float* xp; const float* xs; const float* w_in; const float* b_in; const float* q_gain; const float* k_gain;
  const float* conv_w; const float* conv_b; const float* w_attn_out; const float* w_conv_out; const float* w_o;
  const float* ln_g; const float* ln_b;
  float* out;
  bf16_t* WinT; bf16_t* WaT; bf16_t* WcT; bf16_t* WoT; float* bias_v; float* tab_cos; float* tab_sin;
  bf16_t* xb; bf16_t* Q; bf16_t* Kb; bf16_t* Vt; bf16_t* sza; bf16_t* U; bf16_t* G; bf16_t* sga; bf16_t* sgc; bf16_t* conv; bf16_t* mc;
  unsigned* bar;
};

DI unsigned pk2(float lo, float hi) { f32x2 v = {lo, hi}; return __builtin_bit_cast(unsigned, __builtin_convertvector(v, bf16x2_t)); }
DI float bf2f(unsigned short x) { return __uint_as_float(((unsigned)x) << 16); }
DI float bflo(unsigned w) { return __uint_as_float(w << 16); }
DI float bfhi(unsigned w) { return __uint_as_float(w & 0xffff0000u); }
DI int swz(int r) { return (r & ~12) | ((r & 4) << 1) | ((r & 8) >> 1); }
DI float sigmoidf_(float z) { return __frcp_rn(1.0f + __expf(-z)); }
DI float siluf_(float z) { return z * sigmoidf_(z); }
DI void store8(bf16_t* dst, const float* v) {
  u32x4 w; w.x = pk2(v[0], v[1]); w.y = pk2(v[2], v[3]); w.z = pk2(v[4], v[5]); w.w = pk2(v[6], v[7]);
  *(u32x4*)dst = w;
}
DI void load8(const bf16_t* src, float* v) {
  u32x4 w = *(const u32x4*)src;
  v[0] = bflo(w.x); v[1] = bfhi(w.x); v[2] = bflo(w.y); v[3] = bfhi(w.y); v[4] = bflo(w.z); v[5] = bfhi(w.z); v[6] = bflo(w.w); v[7] = bfhi(w.w);
}
DI void load8f_nt(const float* src, float* v) {
  f32x4 a = __builtin_nontemporal_load((const f32x4*)src), b = __builtin_nontemporal_load((const f32x4*)(src + 4));
  v[0] = a.x; v[1] = a.y; v[2] = a.z; v[3] = a.w; v[4] = b.x; v[5] = b.y; v[6] = b.z; v[7] = b.w;
}
DI void load8f(const float* src, float* v) {
  f32x4 a = *(const f32x4*)src, b = *(const f32x4*)(src + 4);
  v[0] = a.x; v[1] = a.y; v[2] = a.z; v[3] = a.w; v[4] = b.x; v[5] = b.y; v[6] = b.z; v[7] = b.w;
}
DI int vcol(int v) {
  const int g = v >> 6, ni = (v >> 5) & 1, f = v & 31;
  if (g >= 40 && g < 72) { const int cb = g - 40; return (ni ? 4608 : 3584) + 32 * cb + f; }
  if (g >= 72 && g < 104) { const int cb = g - 72; return (ni ? 5632 : 2560) + 32 * cb + f; }
  return v;
}
DI const float* xrow(const Params& p, int R) { return R < 16384 ? p.xp + (size_t)R * D : p.xs + (size_t)(R - 16384) * D; }

__device__ void convert_x(const Params& p, int r0, int r1, int bidx, int nblk) {
  const int gt = bidx * NTHR + TID, gn = nblk * NTHR, i0 = r0 * (D / 8), i1 = r1 * (D / 8);
  for (int i = i0 + gt; i < i1; i += 4 * gn) {
    float v[4][8];
#pragma unroll
    for (int u = 0; u < 4; ++u) { const int ii = i + u * gn; if (ii < i1) load8f_nt(xrow(p, ii >> 7) + (ii & 127) * 8, v[u]); }
#pragma unroll
    for (int u = 0; u < 4; ++u) { const int ii = i + u * gn; if (ii < i1) store8(p.xb + (size_t)(ii >> 7) * PX + (ii & 127) * 8, v[u]); }
  }
}

__device__ void transpose_w(const float* __restrict__ src, int ldsrc, bf16_t* __restrict__ dst, int lddst, int ng32, bool virt, bf16_t* lds) {
  const int tid = TID;
  constexpr int TP = 136;
  for (int tile = BID; tile < ng32 * 8; tile += gridDim.x) {
    const int cgp = tile % ng32, kb = tile / ng32, v0 = cgp * 32, col0 = virt ? vcol(v0) : v0, k0 = kb * 128;
    f32x4 x[2];
#pragma unroll
    for (int ps = 0; ps < 2; ++ps) x[ps] = __builtin_nontemporal_load((const f32x4*)(src + (size_t)(k0 + ps * 64 + (tid >> 3)) * ldsrc + col0 + (tid & 7) * 4));
#pragma unroll
    for (int ps = 0; ps < 2; ++ps)
#pragma unroll
      for (int j = 0; j < 4; ++j) lds[((tid & 7) * 4 + j) * TP + ps * 64 + (tid >> 3)] = (bf16_t)(pk2(x[ps][j], 0.f) & 0xffffu);
    __syncthreads();
    const u32x4 w = *(const u32x4*)(lds + (tid >> 4) * TP + (tid & 15) * 8);
    *(u32x4*)(dst + (size_t)(v0 + (tid >> 4)) * lddst + k0 + (tid & 15) * 8) = w;
    __syncthreads();
  }
}

__device__ void phase_prep(const Params& p, bf16_t* lds) {
  const int gt = BID * NTHR + TID, gn = gridDim.x * NTHR;
  convert_x(p, 0, 16384, BID, gridDim.x);
  transpose_w(p.w_in, INW, p.WinT, PX, INW / 32, true, lds);
  transpose_w(p.w_attn_out, D, p.WaT, D, D / 32, false, lds);
  transpose_w(p.w_conv_out, D, p.WcT, D, D / 32, false, lds);
  transpose_w(p.w_o, D, p.WoT, D, D / 32, false, lds);
  for (int i = gt; i < INW; i += gn) p.bias_v[i] = p.b_in[vcol(i)];
  for (int i = gt; i < 256 * 16; i += gn) {
    const int pos = i >> 4, f = i & 15;
    const float inv = powf(10000.0f, -(float)(2 * f) / 32.0f);
    const float ang = (float)pos * inv;
    p.tab_cos[i] = cosf(ang); p.tab_sin[i] = sinf(ang);
  }
}

enum { EPI_INPROJ = 0, EPI_CONV = 1, EPI_AOUT = 2, EPI_OUT = 3 };

template <int NCH>
DI void flush_rows(const bf16_t* wlt, bf16_t* dst0, int pitch, int lane) {
  constexpr int RPP = 64 / NCH;
#pragma unroll
  for (int ps = 0; ps < 32 / RPP; ++ps) {
    const int row = ps * RPP + lane / NCH, c = lane % NCH;
    const u32x4 w = *(const u32x4*)(wlt + row * SROWE + c * 8);
    *(u32x4*)(dst0 + (size_t)row * pitch + c * 8) = w;
  }
}

template <int EPI>
__device__ void gemm_tile(const Params& p, const bf16_t* __restrict__ Wt, const bf16_t* __restrict__ X, int tile_n, int tile_m, int row0, int S, bf16_t* lds) {
  constexpr int LDW = EPI == EPI_INPROJ ? PX : D, LDX = EPI == EPI_INPROJ ? PX : D;
  const int tid = TID, lane = tid & 63, wid = tid >> 6, wn = wid >> 1, wm = wid & 1, r = lane & 31, h = lane >> 5;
  const int lrow = tid >> 3, lkc = tid & 7;
  const bf16_t* wsrc = Wt + (size_t)(tile_n * 256 + lrow) * LDW + lkc * 8;
  const bf16_t* xsrc = X + (size_t)(tile_m * 256 + lrow) * LDX + lkc * 8;
  const int gq_ = tile_n * 4 + wn;
  const int st_off = lrow * LROW + lkc * 8;
  f32x16 acc[2][4];
#pragma unroll
  for (int a = 0; a < 2; ++a)
#pragma unroll
    for (int b = 0; b < 4; ++b)
#pragma unroll
      for (int i = 0; i < 16; ++i) acc[a][b][i] = 0.f;
  u32x4 rg[8];
#define G_LOAD(k0) { _Pragma("unroll") for (int i = 0; i < 4; ++i) rg[i] = *(const u32x4*)(wsrc + (size_t)i * 64 * LDW + (k0)); \
                     _Pragma("unroll") for (int i = 0; i < 4; ++i) rg[4 + i] = *(const u32x4*)(xsrc + (size_t)i * 64 * LDX + (k0)); }
#define G_STORE() { _Pragma("unroll") for (int i = 0; i < 4; ++i) *(u32x4*)(lds + st_off + i * 64 * LROW) = rg[i]; \
                    _Pragma("unroll") for (int i = 0; i < 4; ++i) *(u32x4*)(lds + WT + st_off + i * 64 * LROW) = rg[4 + i]; }
  const int wfo = (wn * 64 + swz(r)) * LROW + 8 * h;
  const int xfo = WT + (wm * 128 + r) * LROW + 8 * h;
  constexpr int NK = D / BK;
#pragma unroll 1
  for (int pass = 0; pass < (EPI == EPI_AOUT ? 2 : 1); ++pass) {
  if (EPI == EPI_AOUT && pass == 1) {
    wsrc = p.WcT + (size_t)(tile_n * 256 + lrow) * D + lkc * 8; xsrc = p.conv + (size_t)(tile_m * 256 + lrow) * D + lkc * 8;
#pragma unroll
    for (int mb = 0; mb < 2; ++mb) {
      u32x4 ra[2][2][2], rc[2][2][2];
#pragma unroll
      for (int m2 = 0; m2 < 2; ++m2)
#pragma unroll
        for (int ni = 0; ni < 2; ++ni)
#pragma unroll
          for (int run = 0; run < 2; ++run) {
            const size_t off = (size_t)(tile_m * 256 + wm * 128 + (2 * mb + m2) * 32 + r) * D + 64 * gq_ + 32 * ni + 16 * run + 8 * h;
            ra[m2][ni][run] = *(const u32x4*)(p.sga + off); rc[m2][ni][run] = *(const u32x4*)(p.sgc + off);
          }
      __builtin_amdgcn_sched_barrier(0);
#pragma unroll
      for (int m2 = 0; m2 < 2; ++m2)
#pragma unroll
        for (int ni = 0; ni < 2; ++ni)
#pragma unroll
          for (int run = 0; run < 2; ++run)
#pragma unroll
            for (int j = 0; j < 4; ++j) {
              const unsigned wa = ra[m2][ni][run][j], wc = rc[m2][ni][run][j];
              acc[ni][2 * mb + m2][8 * run + 2 * j] *= bflo(wa) * __builtin_amdgcn_rcpf(fmaxf(bflo(wc), 1e-30f));
              acc[ni][2 * mb + m2][8 * run + 2 * j + 1] *= bfhi(wa) * __builtin_amdgcn_rcpf(fmaxf(bfhi(wc), 1e-30f));
            }
      __builtin_amdgcn_sched_barrier(0);
    }
  }
  G_LOAD(0);
#pragma unroll 1
  for (int kt = 0; kt < NK; ++kt) {
    G_STORE();
    __syncthreads();
    if (kt + 1 < NK) G_LOAD((kt + 1) * BK);
    __builtin_amdgcn_sched_barrier(0);
#pragma unroll
    for (int ks = 0; ks < 4; ++ks) {
      bf16x8 wf[2], xf[4];
#pragma unroll
      for (int ni = 0; ni < 2; ++ni) wf[ni] = *(const bf16x8*)(lds + wfo + ni * 32 * LROW + ks * 16);
#pragma unroll
      for (int mi = 0; mi < 4; ++mi) xf[mi] = *(const bf16x8*)(lds + xfo + mi * 32 * LROW + ks * 16);
      __builtin_amdgcn_s_setprio(1);
#pragma unroll
      for (int ni = 0; ni < 2; ++ni)
#pragma unroll
        for (int mi = 0; mi < 4; ++mi) acc[ni][mi] = __builtin_amdgcn_mfma_f32_32x32x16_bf16(wf[ni], xf[mi], acc[ni][mi], 0, 0, 0);
      __builtin_amdgcn_s_setprio(0);
    }
    __builtin_amdgcn_sched_barrier(0);
    __syncthreads();
  }
  }
#undef G_LOAD
#undef G_STORE

  const int g = tile_n * 4 + wn;
  bf16_t* const wlt = lds + (GBUF > 4 * ATILE ? GBUF : 4 * ATILE) + wid * STG;
  bf16_t* const wl = wlt + r * SROWE;
  if (EPI == EPI_INPROJ) {
    {
      float bz[2][16];
#pragma unroll
      for (int ni = 0; ni < 2; ++ni)
#pragma unroll
        for (int run = 0; run < 2; ++run) load8f(p.bias_v + 64 * g + 32 * ni + 16 * run + 8 * h, &bz[ni][8 * run]);
      __builtin_amdgcn_sched_barrier(0);
#pragma unroll
      for (int mi = 0; mi < 4; ++mi)
#pragma unroll
        for (int ni = 0; ni < 2; ++ni)
#pragma unroll
          for (int i = 0; i < 16; ++i) acc[ni][mi][i] += bz[ni][i];
    }
    if (g < 20) {
      const float* gain = g < 16 ? p.q_gain : p.k_gain;
      const float osc = g < 16 ? QSCALE : 1.0f;
      float gn[2][16];
#pragma unroll
      for (int ni = 0; ni < 2; ++ni) { load8f(gain + 32 * ni + 8 * h, &gn[ni][0]); load8f(gain + 32 * ni + 16 + 8 * h, &gn[ni][8]); }
#pragma unroll
      for (int mi = 0; mi < 4; ++mi) {
        const int tl = tile_m * 256 + wm * 128 + mi * 32 + r, t = tl & (S - 1);
        float cs[2][8], sn[2][8];
#pragma unroll
        for (int ni = 0; ni < 2; ++ni) { const int pos = ni ? (t & 63) : (t >> 6); load8f(p.tab_cos + pos * 16 + 8 * h, cs[ni]); load8f(p.tab_sin + pos * 16 + 8 * h, sn[ni]); }
        float ss = 0.f;
#pragma unroll
        for (int ni = 0; ni < 2; ++ni)
#pragma unroll
          for (int i = 0; i < 16; ++i) ss += acc[ni][mi][i] * acc[ni][mi][i];
        ss += __shfl_xor(ss, 32);
        const float rinv = rsqrtf(ss * (1.0f / 64.0f) + 1e-6f);
        const int tl0 = tile_m * 256 + wm * 128 + mi * 32;
        bf16_t* dst0 = g < 16 ? p.Q + (size_t)tl0 * D + 64 * g : p.Kb + (size_t)tl0 * 256 + 64 * (g - 16);
#pragma unroll
        for (int ni = 0; ni < 2; ++ni) {
          float o1[8], o2[8];
#pragma unroll
          for (int j = 0; j < 8; ++j) {
            const float a = acc[ni][mi][j] * rinv * gn[ni][j], b = acc[ni][mi][8 + j] * rinv * gn[ni][8 + j];
            o1[j] = (a * cs[ni][j] - b * sn[ni][j]) * osc; o2[j] = (b * cs[ni][j] + a * sn[ni][j]) * osc;
          }
          store8(wl + 32 * ni + 8 * h, o1); store8(wl + 32 * ni + 16 + 8 * h, o2);
        }
        flush_rows<8>(wlt, dst0, g < 16 ? D : 256, lane);
      }
    } else {
#pragma unroll
      for (int mi = 0; mi < 4; ++mi) {
        const int tl = tile_m * 256 + wm * 128 + mi * 32 + r;
        if (g < 24) {
          const int kvh = g - 20, sl = tl / S, t = tl & (S - 1);
          bf16_t* dst = p.Vt + (size_t)((sl * 4 + kvh) * 64) * S + t;
#pragma unroll
          for (int ni = 0; ni < 2; ++ni)
#pragma unroll
            for (int i = 0; i < 16; ++i) {
              const int d = 32 * ni + (i & 7) + 8 * h + 16 * (i >> 3);
              dst[(size_t)d * S] = (bf16_t)(pk2(acc[ni][mi][i], 0.f) & 0xffffu);
            }
        } else if (g < 40) {
          bf16_t* dst0 = p.sza + (size_t)(tl - r) * D + 64 * (g - 24);
#pragma unroll
          for (int ni = 0; ni < 2; ++ni)
#pragma unroll
            for (int run = 0; run < 2; ++run) {
              float o[8];
#pragma unroll
              for (int j = 0; j < 8; ++j) o[j] = siluf_(acc[ni][mi][8 * run + j]);
              store8(wl + 32 * ni + 16 * run + 8 * h, o);
            }
          flush_rows<8>(wlt, dst0, D, lane);
        } else if (g < 104) {
          const bool isU = g < 72;
          bf16_t* dst0 = (isU ? p.U + 32 * (g - 40) : p.G + 32 * (g - 72)) + (size_t)(tl - r) * D;
#pragma unroll
          for (int run = 0; run < 2; ++run) {
            float o[8];
#pragma unroll
            for (int j = 0; j < 8; ++j) o[j] = isU ? acc[0][mi][8 * run + j] * acc[1][mi][8 * run + j] : acc[0][mi][8 * run + j] * siluf_(acc[1][mi][8 * run + j]);
            store8(wl + 16 * run + 8 * h, o);
          }
          flush_rows<4>(wlt, dst0, D, lane);
        } else {
          bf16_t* dst0 = (g < 120 ? p.sga + 64 * (g - 104) : p.sgc + 64 * (g - 120)) + (size_t)(tl - r) * D;
#pragma unroll
          for (int ni = 0; ni < 2; ++ni)
#pragma unroll
            for (int run = 0; run < 2; ++run) {
              float o[8];
#pragma unroll
              for (int j = 0; j < 8; ++j) o[j] = sigmoidf_(acc[ni][mi][8 * run + j]);
              store8(wl + 32 * ni + 16 * run + 8 * h, o);
            }
          flush_rows<8>(wlt, dst0, D, lane);
        }
      }
    }
  }
  if (EPI == EPI_AOUT) {
    u32x4 rc[4][2][2];
#pragma unroll
    for (int mi = 0; mi < 4; ++mi)
#pragma unroll
      for (int ni = 0; ni < 2; ++ni)
#pragma unroll
        for (int run = 0; run < 2; ++run)
          rc[mi][ni][run] = *(const u32x4*)(p.sgc + (size_t)(tile_m * 256 + wm * 128 + mi * 32 + r) * D + 64 * g + 32 * ni + 16 * run + 8 * h);
    __builtin_amdgcn_sched_barrier(0);
#pragma unroll
    for (int mi = 0; mi < 4; ++mi)
#pragma unroll
      for (int ni = 0; ni < 2; ++ni)
#pragma unroll
        for (int run = 0; run < 2; ++run) {
          float o[8];
#pragma unroll
          for (int j = 0; j < 4; ++j) { const unsigned wc = rc[mi][ni][run][j]; o[2 * j] = acc[ni][mi][8 * run + 2 * j] * bflo(wc); o[2 * j + 1] = acc[ni][mi][8 * run + 2 * j + 1] * bfhi(wc); }
          store8(wl + 32 * ni + 16 * run + 8 * h, o);
          if (ni == 1 && run == 1) flush_rows<8>(wlt, p.G + (size_t)(tile_m * 256 + wm * 128 + mi * 32) * D + 64 * g, D, lane);
        }
  }
  if (EPI == EPI_OUT) {
#pragma unroll
    for (int mb = 0; mb < 2; ++mb) {
      f32x4 xr[2][2][2][2];
#pragma unroll
      for (int m2 = 0; m2 < 2; ++m2)
#pragma unroll
        for (int ni = 0; ni < 2; ++ni)
#pragma unroll
          for (int run = 0; run < 2; ++run) {
            const int tl = tile_m * 256 + wm * 128 + (2 * mb + m2) * 32 + r;
            const float* xp_ = xrow(p, row0 + tl) + 64 * g + 32 * ni + 16 * run + 8 * h;
            xr[m2][ni][run][0] = *(const f32x4*)xp_; xr[m2][ni][run][1] = *(const f32x4*)(xp_ + 4);
          }
      __builtin_amdgcn_sched_barrier(0);
#pragma unroll
      for (int m2 = 0; m2 < 2; ++m2)
#pragma unroll
        for (int ni = 0; ni < 2; ++ni)
#pragma unroll
          for (int run = 0; run < 2; ++run) {
            const int mi = 2 * mb + m2, tl = tile_m * 256 + wm * 128 + mi * 32 + r;
            float* dst = p.out + (size_t)(row0 + tl) * D + 64 * g + 32 * ni + 16 * run + 8 * h;
            f32x4 a, b;
#pragma unroll
            for (int j = 0; j < 4; ++j) { a[j] = DN_ALPHA * xr[m2][ni][run][0][j] + acc[ni][mi][8 * run + j]; b[j] = DN_ALPHA * xr[m2][ni][run][1][j] + acc[ni][mi][8 * run + 4 + j]; }
            *(f32x4*)dst = a; *(f32x4*)(dst + 4) = b;
          }
      __builtin_amdgcn_sched_barrier(0);
    }
  }
}

__device__ void phase_conv(const Params& p, int S, int nrows) {
  const int gt = BID * NTHR + TID, gn = gridDim.x * NTHR;
  for (int i = gt; i < (nrows >> 2) * 128; i += gn) {
    const int tl0 = (i >> 7) * 4, c8 = (i & 127) * 8, t0 = tl0 & (S - 1);
    float u[6][8], gg[4][8], w0[8], w1[8], w2[8], b[8];
    const bf16_t* up_ = p.U + (size_t)tl0 * D + c8;
    if (t0 > 0) load8(up_ - D, u[0]); else {
#pragma unroll
      for (int j = 0; j < 8; ++j) u[0][j] = 0.f; }
#pragma unroll
    for (int k = 0; k < 4; ++k) load8(up_ + (size_t)k * D, u[k + 1]);
    if (t0 + 4 < S) load8(up_ + (size_t)4 * D, u[5]); else {
#pragma unroll
      for (int j = 0; j < 8; ++j) u[5][j] = 0.f; }
#pragma unroll
    for (int k = 0; k < 4; ++k) load8(p.G + (size_t)(tl0 + k) * D + c8, gg[k]);
    load8f(p.conv_w + c8, w0); load8f(p.conv_w + D + c8, w1); load8f(p.conv_w + 2 * D + c8, w2); load8f(p.conv_b + c8, b);
#pragma unroll
    for (int k = 0; k < 4; ++k) {
      float o[8];
#pragma unroll
      for (int j = 0; j < 8; ++j) o[j] = gg[k][j] * (w0[j] * u[k][j] + w1[j] * u[k + 1][j] + w2[j] * u[k + 2][j] + b[j]);
      store8(p.conv + (size_t)(tl0 + k) * D + c8, o);
    }
  }
}

__device__ void attn_unit(const Params& p, int S, int unit, bf16_t* lds) {
  const int tid = TID, lane = tid & 63, wid = tid >> 6, r = lane & 31, h = lane >> 5;
  const int nqb = S >> 9;
  const int qb = unit % nqb, hq4 = (unit / nqb) & 3, kvh = (unit / (4 * nqb)) & 3, sl = unit / (16 * nqb);
  const int head = kvh * 4 + hq4;
  float gq = fabsf(p.q_gain[lane]), gk = fabsf(p.k_gain[lane]);
#pragma unroll
  for (int o = 32; o > 0; o >>= 1) { gq = fmaxf(gq, __shfl_xor(gq, o)); gk = fmaxf(gk, __shfl_xor(gk, o)); }
  const float negM = -(64.0f * gq * gk * QSCALE * 1.02f);
  const int tq = sl * S + qb * 512 + wid * 64 + r;
  bf16x8 qf[2][4];
#pragma unroll
  for (int q2 = 0; q2 < 2; ++q2)
#pragma unroll
    for (int st = 0; st < 4; ++st) qf[q2][st] = *(const bf16x8*)(p.Q + (size_t)(tq + 32 * q2) * D + head * 64 + 16 * st + 8 * h);
  const bf16_t* Kg = p.Kb + (size_t)(sl * S) * 256 + kvh * 64;
  const bf16_t* Vg = p.Vt + (size_t)((sl * 4 + kvh) * 64) * S;
  const int lr = tid >> 3, lc = (tid & 7) * 8;
  const bf16_t* ksrc = Kg + (size_t)lr * 256 + lc;
  const bf16_t* vsrc = Vg + (size_t)lr * S + lc;
  const int st_off = lr * AROW + lc;
  u32x4 ta[2];
#define A_LOAD(R, kk) { const size_t kk_ = (size_t)(kk); R[0] = *(const u32x4*)(ksrc + kk_ * 256); R[1] = *(const u32x4*)(vsrc + kk_); }
#define A_STORE(R, buf) { bf16_t* sb_ = lds + (buf) * 2 * ATILE; *(u32x4*)(sb_ + st_off) = R[0]; *(u32x4*)(sb_ + ATILE + st_off) = R[1]; }
  f32x16 o[2][2];
#pragma unroll
  for (int a = 0; a < 2; ++a)
#pragma unroll
    for (int b = 0; b < 2; ++b)
#pragma unroll
      for (int i = 0; i < 16; ++i) o[a][b][i] = 0.f;
  float ls[2] = {0.f, 0.f};
  const int fo = swz(r) * AROW + 8 * h;
  const int nt = S >> 6;
#define A_COMPUTE(buf) { const bf16_t* kb_ = lds + (buf) * 2 * ATILE; const bf16_t* vb_ = kb_ + ATILE; \
    _Pragma("unroll") for (int kb = 0; kb < 2; ++kb) { \
      __builtin_amdgcn_sched_barrier(0); \
      bf16x8 kf[4], vf[2][2]; \
      _Pragma("unroll") for (int st = 0; st < 4; ++st) kf[st] = *(const bf16x8*)(kb_ + fo + kb * 32 * AROW + 16 * st); \
      _Pragma("unroll") for (int sp = 0; sp < 2; ++sp) _Pragma("unroll") for (int dt = 0; dt < 2; ++dt) vf[sp][dt] = *(const bf16x8*)(vb_ + fo + dt * 32 * AROW + kb * 32 + sp * 16); \
      f32x16 sx[2]; \
      _Pragma("unroll") for (int q2 = 0; q2 < 2; ++q2) _Pragma("unroll") for (int i = 0; i < 16; ++i) sx[q2][i] = negM; \
      __builtin_amdgcn_s_setprio(1); \
      _Pragma("unroll") for (int st = 0; st < 4; ++st) _Pragma("unroll") for (int q2 = 0; q2 < 2; ++q2) sx[q2] = __builtin_amdgcn_mfma_f32_32x32x16_bf16(kf[st], qf[q2][st], sx[q2], 0, 0, 0); \
      __builtin_amdgcn_s_setprio(0); \
      bf16x8 pf[2][2]; \
      _Pragma("unroll") for (int q2 = 0; q2 < 2; ++q2) { \
        _Pragma("unroll") for (int i = 0; i < 16; ++i) { sx[q2][i] = __builtin_amdgcn_exp2f(sx[q2][i]); ls[q2] += sx[q2][i]; } \
        _Pragma("unroll") for (int sp = 0; sp < 2; ++sp) { u32x4 pw; \
          pw.x = pk2(sx[q2][8 * sp + 0], sx[q2][8 * sp + 1]); pw.y = pk2(sx[q2][8 * sp + 2], sx[q2][8 * sp + 3]); \
          pw.z = pk2(sx[q2][8 * sp + 4], sx[q2][8 * sp + 5]); pw.w = pk2(sx[q2][8 * sp + 6], sx[q2][8 * sp + 7]); \
          pf[q2][sp] = __builtin_bit_cast(bf16x8, pw); } } \
      __builtin_amdgcn_s_setprio(1); \
      _Pragma("unroll") for (int sp = 0; sp < 2; ++sp) _Pragma("unroll") for (int dt = 0; dt < 2; ++dt) _Pragma("unroll") for (int q2 = 0; q2 < 2; ++q2) \
        o[q2][dt] = __builtin_amdgcn_mfma_f32_32x32x16_bf16(vf[sp][dt], pf[q2][sp], o[q2][dt], 0, 0, 0); \
      __builtin_amdgcn_s_setprio(0); } }
  A_LOAD(ta, 0);
  A_STORE(ta, 0);
  __syncthreads();
#pragma unroll 1
  for (int it = 0; it < nt; ++it) {
    const bool more = it + 1 < nt;
    if (more) A_LOAD(ta, (it + 1) * 64);
    __builtin_amdgcn_sched_barrier(0);
    const int bsel = it & 1;
    A_COMPUTE(bsel);
    __builtin_amdgcn_sched_barrier(0);
    if (more) A_STORE(ta, bsel ^ 1);
    __syncthreads();
  }
#undef A_LOAD
#undef A_STORE
#undef A_COMPUTE
  u32x4 zr[2][2][2];
#pragma unroll
  for (int q2 = 0; q2 < 2; ++q2)
#pragma unroll
    for (int dt = 0; dt < 2; ++dt)
#pragma unroll
      for (int run = 0; run < 2; ++run) zr[q2][dt][run] = *(const u32x4*)(p.sza + (size_t)(tq + 32 * q2) * D + head * 64 + 32 * dt + 16 * run + 8 * h);
  __builtin_amdgcn_sched_barrier(0);
#pragma unroll
  for (int q2 = 0; q2 < 2; ++q2) {
    float lsum = ls[q2];
    lsum += __shfl_xor(lsum, 32);
    const float inv = __frcp_rn(lsum);
#pragma unroll
    for (int dt = 0; dt < 2; ++dt)
#pragma unroll
      for (int run = 0; run < 2; ++run) {
        const size_t off = (size_t)(tq + 32 * q2) * D + head * 64 + 32 * dt + 16 * run + 8 * h;
        float w[8];
#pragma unroll
        for (int j = 0; j < 4; ++j) { const unsigned z = zr[q2][dt][run][j]; w[2 * j] = o[q2][dt][8 * run + 2 * j] * inv * bflo(z); w[2 * j + 1] = o[q2][dt][8 * run + 2 * j + 1] * inv * bfhi(z); }
        store8(lds + (GBUF > 4 * ATILE ? GBUF : 4 * ATILE) + wid * STG + r * SROWE + 32 * dt + 16 * run + 8 * h, w);
        (void)off;
      }
    flush_rows<8>(lds + (GBUF > 4 * ATILE ? GBUF : 4 * ATILE) + wid * STG, p.Q + (size_t)(tq - r + 32 * q2) * D + head * 64, D, lane);
  }
}

__device__ void phase_ln(const Params& p, int row0, int nrows) {
  const int tid = TID, lane = tid & 63, wid = tid >> 6;
  f32x4 gg[4], bb[4];
#pragma unroll
  for (int i = 0; i < 4; ++i) { gg[i] = *(const f32x4*)(p.ln_g + i * 256 + lane * 4); bb[i] = *(const f32x4*)(p.ln_b + i * 256 + lane * 4); }
  constexpr int LNR = 4;
  for (int rr = (BID * (NTHR / 64) + wid) * LNR; rr < nrows; rr += gridDim.x * (NTHR / 64) * LNR) {
    float* row = p.out + (size_t)(row0 + rr) * D;
    f32x4 v[LNR][4];
    float s[LNR];
#pragma unroll
    for (int u = 0; u < LNR; ++u) s[u] = 0.f;
#pragma unroll
    for (int u = 0; u < LNR; ++u)
#pragma unroll
      for (int i = 0; i < 4; ++i) { v[u][i] = __builtin_nontemporal_load((const f32x4*)(row + u * D + i * 256 + lane * 4)); s[u] += (v[u][i].x + v[u][i].y) + (v[u][i].z + v[u][i].w); }
#pragma unroll
    for (int o = 32; o > 0; o >>= 1) {
#pragma unroll
      for (int u = 0; u < LNR; ++u) s[u] += __shfl_xor(s[u], o); }
#pragma unroll
    for (int u = 0; u < LNR; ++u) {
      const float mu = s[u] * (1.0f / D);
      float q = 0.f;
#pragma unroll
      for (int i = 0; i < 4; ++i) { v[u][i] = v[u][i] - mu; q += (v[u][i].x * v[u][i].x + v[u][i].y * v[u][i].y) + (v[u][i].z * v[u][i].z + v[u][i].w * v[u][i].w); }
#pragma unroll
      for (int o = 32; o > 0; o >>= 1) q += __shfl_xor(q, o);
      const float rstd = rsqrtf(q * (1.0f / D) + 1e-5f);
#pragma unroll
      for (int i = 0; i < 4; ++i) __builtin_nontemporal_store(v[u][i] * rstd * gg[i] + bb[i], (f32x4*)(row + u * D + i * 256 + lane * 4));
    }
  }
}

#define XB_TMO      128
#define XB_XCNT(j)  (256  + 64 * (j))
#define XB_XSUB(j)  (1280 + 64 * (j))
#define XB_XGEN(j)  (2304 + 64 * (j))
#define XB_TOP      3328
#define XB_TOPGEN   3392
#define XCD_BAR_WORDS 3456
#define XB_SPIN_CAP (1u << 22)
DI unsigned xb_ld(unsigned* p) { return __hip_atomic_load(p, __ATOMIC_RELAXED, __HIP_MEMORY_SCOPE_AGENT); }
DI unsigned xb_add(unsigned* p, unsigned v) { return __hip_atomic_fetch_add(p, v, __ATOMIC_RELAXED, __HIP_MEMORY_SCOPE_AGENT); }
DI unsigned xb_xcc_id() { return (unsigned)__builtin_amdgcn_s_getreg((3 << 11) | 20) & 0xFu; }
#define XB_SPIN(cond, bar) do { unsigned _sp = 0; while (cond) { __builtin_amdgcn_s_sleep(1); \
    if ((++_sp & 255u) == 0u) { if (xb_ld(&(bar)[XB_TMO])) break; if (_sp > XB_SPIN_CAP) { atomicAdd(&(bar)[XB_TMO], 1u); break; } } } } while (0)
DI void xcd_barrier_complete(unsigned* bar, unsigned x, unsigned& nloc, unsigned& nx) {
  const unsigned G = gridDim.x;
  unsigned sum, cnt, mine, sp = 0u;
  for (;;) {
    sum = 0u; cnt = 0u; mine = 0u;
#pragma unroll
    for (unsigned j = 0; j < 16; ++j) { const unsigned c = xb_ld(&bar[XB_XCNT(j)]); sum += c; cnt += (c > 0u) ? 1u : 0u; mine = (j == x) ? c : mine; }
    if (sum == G) break;
    __builtin_amdgcn_s_sleep(1);
    if ((++sp & 255u) == 0u) { if (xb_ld(&bar[XB_TMO])) break; if (sp > XB_SPIN_CAP) { atomicAdd(&bar[XB_TMO], 1u); break; } }
  }
  nloc = mine > 0u ? mine : 1u; nx = cnt > 0u ? cnt : 1u;
}
#define LAS __attribute__((address_space(3)))
DI void xcd_barrier(unsigned* bar, unsigned x, volatile LAS unsigned* st) {
  asm volatile("s_waitcnt vmcnt(0)" ::: "memory");
  __syncthreads();
  if (threadIdx.x == 0) {
    __builtin_amdgcn_s_waitcnt(0);
    unsigned nloc = st[0], nx = st[1];
    if (nloc == 0u) { xcd_barrier_complete(bar, x, nloc, nx); st[0] = nloc; st[1] = nx; }
    const unsigned old = xb_add(&bar[XB_XSUB(x)], 1u);
    const unsigned gen = old / nloc;
    if (old + 1u == (gen + 1u) * nloc) {
      __builtin_amdgcn_fence(__ATOMIC_RELEASE, "agent");
      asm volatile("s_waitcnt vmcnt(0)" ::: "memory");
      const unsigned og = xb_add(&bar[XB_TOP], 1u);
      const unsigned tg = og / nx;
      if (og + 1u == (tg + 1u) * nx) xb_add(&bar[XB_TOPGEN], 1u);
      else XB_SPIN(xb_ld(&bar[XB_TOPGEN]) == tg, bar);
      __builtin_amdgcn_fence(__ATOMIC_ACQUIRE, "agent");
      xb_add(&bar[XB_XGEN(x)], 1u);
      asm volatile("s_waitcnt vmcnt(0)" ::: "memory");
    } else {
      XB_SPIN(xb_ld(&bar[XB_XGEN(x)]) == gen, bar);
      __builtin_amdgcn_fence(__ATOMIC_ACQUIRE, "agent");
      asm volatile("s_waitcnt vmcnt(0)" ::: "memory");
    }
  }
  __syncthreads();
}

__device__ void run_phase(const Params& p, int ph, bf16_t* lds) {
  if (ph == 0) { phase_prep(p, lds); return; }
  if (ph == NPHASE - 1) { phase_ln(p, 16384, 32768); return; }
  const int c = (ph - 1) / 4, sub = (ph - 1) % 4, row0 = c ? 16384 : 0, nrows = c ? 32768 : 16384, S = c ? 4096 : 16384;
  const int lgmx = c ? 4 : 3, MX = 1 << lgmx, MT = 8 * MX;
  if (sub == 0) {
    const bf16_t* X = p.xb + (size_t)row0 * PX;
    for (int id = BID; id < 34 * MT; id += gridDim.x) {
      const int xcd = id & 7, j = id >> 3, n = j >> lgmx, m = MX * xcd + (j & (MX - 1));
      gemm_tile<EPI_INPROJ>(p, p.WinT, X, n, m, row0, S, lds);
    }
    if (c > 0) phase_ln(p, 0, 16384);
    else {
      const int G = gridDim.x, rem = (34 * MT) % G, b = BID;
      if (rem == 0) convert_x(p, 16384, T_ALL, b, G);
      else if (b >= rem) convert_x(p, 16384, T_ALL, b - rem, G - rem);
    }
  } else if (sub == 1) {
    const int nunits = nrows >> 5, UX = nunits >> 3;
    const bool conv_first = ((BID >> 3) & 1) != 0;
    if (conv_first) phase_conv(p, S, nrows);
    for (int id = BID; id < nunits; id += gridDim.x) attn_unit(p, S, UX * (id & 7) + (id >> 3), lds);
    if (!conv_first) phase_conv(p, S, nrows);
  } else if (sub == 2) {
    for (int id = BID; id < 4 * MT; id += gridDim.x) { const int j = id >> 3; gemm_tile<EPI_AOUT>(p, p.WaT, p.Q, j & 3, MX * (id & 7) + (j >> 2), row0, S, lds); }
  } else {
    for (int id = BID; id < 4 * MT; id += gridDim.x) { const int j = id >> 3; gemm_tile<EPI_OUT>(p, p.WoT, p.G, j & 3, MX * (id & 7) + (j >> 2), row0, S, lds); }
  }
}

__global__ void __launch_bounds__(NTHR, 2) mega(Params p, int ph_begin, int ph_end) {
  __shared__ __attribute__((aligned(16))) bf16_t lds[LDS_ELEMS];
  __shared__ uint4 xb_words;
  if (threadIdx.x == 0) xb_words = make_uint4(0u, 0u, 0u, 0u);
  __syncthreads();
  const unsigned xcc = xb_xcc_id();
  if (threadIdx.x == 0 && ph_end - ph_begin > 1) (void)xb_add(&p.bar[XB_XCNT(xcc)], 1u);
  if (ph_begin < 0) cg::this_grid().sync();
  for (int ph = ph_begin; ph < ph_end; ++ph) {
    run_phase(p, ph, lds);
    if (ph + 1 < ph_end) xcd_barrier(p.bar, xcc, (volatile LAS unsigned*)&xb_words);
  }
}

extern "C" void kernel_launch(void* const* d_in, const int* in_sizes, int n_in, void* d_out, int out_size, void* d_ws, size_t ws_size, hipStream_t stream) {
  static int grid_blocks = 0;
  if (!grid_blocks) {
    int dev = 0, cus = 0, per_cu = 0;
    hipGetDevice(&dev);
    hipDeviceGetAttribute(&cus, hipDeviceAttributeMultiprocessorCount, dev);
    hipOccupancyMaxActiveBlocksPerMultiprocessor(&per_cu, mega, NTHR, 0);
    if (per_cu > 1) per_cu = 1;
    if (per_cu < 1) per_cu = 1;
    if (per_cu > 4) per_cu = 4;
    grid_blocks = cus * per_cu;
  }
  Params p{};
  p.xp = (const float*)d_in[0]; p.xs = (const float*)d_in[1]; p.w_in = (const float*)d_in[2]; p.b_in = (const float*)d_in[3];
  p.q_gain = (const float*)d_in[4]; p.k_gain = (const float*)d_in[5]; p.conv_w = (const float*)d_in[6]; p.conv_b = (const float*)d_in[7];
  p.w_attn_out = (const float*)d_in[8]; p.w_conv_out = (const float*)d_in[9]; p.w_o = (const float*)d_in[10];
  p.ln_g = (const float*)d_in[11]; p.ln_b = (const float*)d_in[12];
  p.out = (float*)d_out;
  char* w = (char*)d_ws; size_t off = 0;
  auto take = [&](size_t bytes) { char* q = w + off; off += (bytes + 255) & ~(size_t)255; return q; };
  p.WinT = (bf16_t*)take((size_t)INW * PX * 2);
  p.WaT = (bf16_t*)take((size_t)D * D * 2); p.WcT = (bf16_t*)take((size_t)D * D * 2); p.WoT = (bf16_t*)take((size_t)D * D * 2);
  p.bias_v = (float*)take(INW * 4); p.tab_cos = (float*)take(256 * 16 * 4); p.tab_sin = (float*)take(256 * 16 * 4);
  p.xb = (bf16_t*)take((size_t)T_ALL * PX * 2);
  p.Q = (bf16_t*)take((size_t)CHMAX * D * 2); p.Kb = (bf16_t*)take((size_t)CHMAX * 256 * 2); p.Vt = (bf16_t*)take((size_t)CHMAX * 256 * 2);
  p.sza = (bf16_t*)take((size_t)CHMAX * D * 2); p.U = (bf16_t*)take((size_t)CHMAX * D * 2); p.G = (bf16_t*)take((size_t)CHMAX * D * 2);
  p.sga = (bf16_t*)take((size_t)CHMAX * D * 2); p.sgc = (bf16_t*)take((size_t)CHMAX * D * 2); p.conv = (bf16_t*)take((size_t)CHMAX * D * 2);
  p.mc = p.sgc;
  p.bar = (unsigned*)take(XCD_BAR_WORDS * 4);
  if (off > ws_size) { fprintf(stderr, "workspace too small: need %zu have %zu\n", off, ws_size); return; }
#if MK_SINGLE
  hipMemsetAsync(p.bar, 0, XCD_BAR_WORDS * 4, stream);
  int b = 0, e = NPHASE;
  void* args[] = {&p, &b, &e};
  hipError_t err = hipLaunchCooperativeKernel((void*)mega, dim3(grid_blocks), dim3(NTHR), args, 0, stream);
  if (err != hipSuccess) fprintf(stderr, "cooperative launch failed: %s (grid %d)\n", hipGetErrorString(err), grid_blocks);
#else
  for (int ph = 0; ph < NPHASE; ++ph) hipLaunchKernelGGL(mega, dim3(grid_blocks), dim3(NTHR), 0, stream, p, ph, ph + 1);
#endif
}
```

```cpp
#include <hip/hip_runtime.h>
#include <hip/hip_cooperative_groups.h>
#include <cstdio>
#include <cstdint>
namespace cg = cooperative_groups;

#ifndef ATT_C
#define ATT_C 1.0f
#endif
#ifndef OSC
#define OSC 1.0f
#endif
#ifndef MK_SINGLE
#define MK_SINGLE 1
#endif

typedef unsigned short bf16_t;
typedef short bf16x8 __attribute__((ext_vector_type(8)));
typedef float f32x16 __attribute__((ext_vector_type(16)));
typedef float f32x4 __attribute__((ext_vector_type(4)));
typedef float f32x2 __attribute__((ext_vector_type(2)));
typedef unsigned u32x4 __attribute__((ext_vector_type(4)));
typedef __bf16 bf16x2_t __attribute__((ext_vector_type(2)));
#define DI __device__ __forceinline__
DI int opq_v(int t) { asm volatile("" : "+v"(t)); return t; }
DI int opq_s(int t) { asm volatile("" : "+s"(t)); return t; }
#define TID (opq_v((int)threadIdx.x))
#define BID (opq_s((int)blockIdx.x))

constexpr int D = 1024, INW = 8704, T_ALL = 49152, CHMAX = 32768;
constexpr int BK = 64, LROW = BK + 8, WT = 256 * LROW, XT = 256 * LROW, GBUF = WT + XT;
constexpr int AROW = 72, ATILE = 64 * AROW;
constexpr int SROWE = 72, STG = 32 * SROWE;
constexpr int LDS_ELEMS = (GBUF > 4 * ATILE ? GBUF : 4 * ATILE) + 8 * STG;
constexpr float QSCALE = 0.125f * 1.4426950408889634f;
constexpr float DN_ALPHA = 1.189207115002721f;
constexpr int NPHASE = 10;
constexpr int NTHR = 512;
constexpr int PX = 1088;

struct Params {
  const float* xp; const float* xs; const float* w_in; const float* b_in; const float* q_gain; const float* k_gain;
  const float* conv_w; const float* conv_b; const float* w_attn_out; const float* w_conv_out; const float* w_o;
  const float* ln_g; const float* ln_b;
  float* out;
  bf16_t* WinT; bf16_t* WaT; bf16_t* WcT; bf16_t* WoT; float* bias_v; float* tab_cos; float* tab_sin;
  bf16_t* xb; bf16_t* Q; bf16_t* Kb; bf16_t* Vt; bf16_t* sza; bf16_t* U; bf16_t* G; bf16_t* sga; bf16_t* sgc; bf16_t* conv; bf16_t* mc;
  unsigned* bar;
};

DI unsigned pk2(float lo, float hi) { f32x2 v = {lo, hi}; return __builtin_bit_cast(unsigned, __builtin_convertvector(v, bf16x2_t)); }
DI float bf2f(unsigned short x) { return __uint_as_float(((unsigned)x) << 16); }
DI float bflo(unsigned w) { return __uint_as_float(w << 16); }
DI float bfhi(unsigned w) { return __uint_as_float(w & 0xffff0000u); }
DI int swz(int r) { return (r & ~12) | ((r & 4) << 1) | ((r & 8) >> 1); }
DI float sigmoidf_(float z) { return __frcp_rn(1.0f + __expf(-z)); }
DI float siluf_(float z) { return z * sigmoidf_(z); }
DI void store8(bf16_t* dst, const float* v) {
  u32x4 w; w.x = pk2(v[0], v[1]); w.y = pk2(v[2], v[3]); w.z = pk2(v[4], v[5]); w.w = pk2(v[6], v[7]);
  *(u32x4*)dst = w;
}
DI void store8_nt(bf16_t* dst, const float* v) {
  u32x4 w; w.x = pk2(v[0], v[1]); w.y = pk2(v[2], v[3]); w.z = pk2(v[4], v[5]); w.w = pk2(v[6], v[7]);
  __builtin_nontemporal_store(w, (u32x4*)dst);
}
DI void load8(const bf16_t* src, float* v) {
  u32x4 w = *(const u32x4*)src;
  v[0] = bflo(w.x); v[1] = bfhi(w.x); v[2] = bflo(w.y); v[3] = bfhi(w.y); v[4] = bflo(w.z); v[5] = bfhi(w.z); v[6] = bflo(w.w); v[7] = bfhi(w.w);
}
DI void load8f_nt(const float* src, float* v) {
  f32x4 a = __builtin_nontemporal_load((const f32x4*)src), b = __builtin_nontemporal_load((const f32x4*)(src + 4));
  v[0] = a.x; v[1] = a.y; v[2] = a.z; v[3] = a.w; v[4] = b.x; v[5] = b.y; v[6] = b.z; v[7] = b.w;
}
DI void load8f(const float* src, float* v) {
  f32x4 a = *(const f32x4*)src, b = *(const f32x4*)(src + 4);
  v[0] = a.x; v[1] = a.y; v[2] = a.z; v[3] = a.w; v[4] = b.x; v[5] = b.y; v[6] = b.z; v[7] = b.w;
}
DI int vcol(int v) {
  const int g = v >> 6, ni = (v >> 5) & 1, f = v & 31;
  if (g >= 40 && g < 72) { const int cb = g - 40; return (ni ? 4608 : 3584) + 32 * cb + f; }
  if (g >= 72 && g < 104) { const int cb = g - 72; return (ni ? 5632 : 2560) + 32 * cb + f; }
  return v;
}
DI const float* xrow(const Params& p, int R) { return R < 16384 ? p.xp + (size_t)R * D : p.xs + (size_t)(R - 16384) * D; }

__device__ void convert_x(const Params& p, int r0, int r1, int bidx, int nblk) {
  const int gt = bidx * NTHR + TID, gn = nblk * NTHR, i0 = r0 * (D / 8), i1 = r1 * (D / 8);
  for (int i = i0 + gt; i < i1; i += 4 * gn) {
    float v[4][8];
#pragma unroll
    for (int u = 0; u < 4; ++u) { const int ii = i + u * gn; if (ii < i1) load8f_nt(xrow(p, ii >> 7) + (ii & 127) * 8, v[u]); }
#pragma unroll
    for (int u = 0; u < 4; ++u) { const int ii = i + u * gn; if (ii < i1) { if (r0 >= 16384) store8_nt(p.xb + (size_t)(ii >> 7) * PX + (ii & 127) * 8, v[u]); else store8(p.xb + (size_t)(ii >> 7) * PX + (ii & 127) * 8, v[u]); } }
  }
}

__device__ void transpose_w(const float* __restrict__ src, int ldsrc, bf16_t* __restrict__ dst, int lddst, int ng32, bool virt, bf16_t* lds) {
  const int tid = TID;
  constexpr int TP = 136;
  for (int tile = BID; tile < ng32 * 8; tile += gridDim.x) {
    const int cgp = tile % ng32, kb = tile / ng32, v0 = cgp * 32, col0 = virt ? vcol(v0) : v0, k0 = kb * 128;
    f32x4 x[2];
#pragma unroll
    for (int ps = 0; ps < 2; ++ps) x[ps] = __builtin_nontemporal_load((const f32x4*)(src + (size_t)(k0 + ps * 64 + (tid >> 3)) * ldsrc + col0 + (tid & 7) * 4));
#pragma unroll
    for (int ps = 0; ps < 2; ++ps)
#pragma unroll
      for (int j = 0; j < 4; ++j) lds[((tid & 7) * 4 + j) * TP + ps * 64 + (tid >> 3)] = (bf16_t)(pk2(x[ps][j], 0.f) & 0xffffu);
    __syncthreads();
    const u32x4 w = *(const u32x4*)(lds + (tid >> 4) * TP + (tid & 15) * 8);
    *(u32x4*)(dst + (size_t)(v0 + (tid >> 4)) * lddst + k0 + (tid & 15) * 8) = w;
    __syncthreads();
  }
}

__device__ void phase_prep(const Params& p, bf16_t* lds) {
  const int gt = BID * NTHR + TID, gn = gridDim.x * NTHR;
  convert_x(p, 0, 16384, BID, gridDim.x);
  transpose_w(p.w_in, INW, p.WinT, PX, INW / 32, true, lds);
  transpose_w(p.w_attn_out, D, p.WaT, D, D / 32, false, lds);
  transpose_w(p.w_conv_out, D, p.WcT, D, D / 32, false, lds);
  transpose_w(p.w_o, D, p.WoT, D, D / 32, false, lds);
  for (int i = gt; i < INW; i += gn) p.bias_v[i] = p.b_in[vcol(i)];
  for (int i = gt; i < 256 * 16; i += gn) {
    const int pos = i >> 4, f = i & 15;
    const float inv = powf(10000.0f, -(float)(2 * f) / 32.0f);
    const float ang = (float)pos * inv;
    p.tab_cos[i] = cosf(ang); p.tab_sin[i] = sinf(ang);
  }
}

enum { EPI_INPROJ = 0, EPI_CONV = 1, EPI_AOUT = 2, EPI_OUT = 3 };

template <int NCH>
DI void flush_rows(const bf16_t* wlt, bf16_t* dst0, int pitch, int lane) {
  constexpr int RPP = 64 / NCH;
#pragma unroll
  for (int ps = 0; ps < 32 / RPP; ++ps) {
    const int row = ps * RPP + lane / NCH, c = lane % NCH;
    const u32x4 w = *(const u32x4*)(wlt + row * SROWE + c * 8);
    *(u32x4*)(dst0 + (size_t)row * pitch + c * 8) = w;
  }
}

template <int EPI>
__device__ void gemm_tile(const Params& p, const bf16_t* __restrict__ Wt, const bf16_t* __restrict__ X, int tile_n, int tile_m, int row0, int S, bf16_t* lds) {
  constexpr int LDW = EPI == EPI_INPROJ ? PX : D, LDX = EPI == EPI_INPROJ ? PX : D;
  const int tid = TID, lane = tid & 63, wid = tid >> 6, wn = wid >> 1, wm = wid & 1, r = lane & 31, h = lane >> 5;
  const int lrow = tid >> 3, lkc = tid & 7;
  const bf16_t* wsrc = Wt + (size_t)(tile_n * 256 + lrow) * LDW + lkc * 8;
  const bf16_t* xsrc = X + (size_t)(tile_m * 256 + lrow) * LDX + lkc * 8;
  const int gq_ = tile_n * 4 + wn;
  const int st_off = lrow * LROW + lkc * 8;
  f32x16 acc[2][4];
#pragma unroll
  for (int a = 0; a < 2; ++a)
#pragma unroll
    for (int b = 0; b < 4; ++b)
#pragma unroll
      for (int i = 0; i < 16; ++i) acc[a][b][i] = 0.f;
  u32x4 rg[8];
#define G_LOAD(k0) { _Pragma("unroll") for (int i = 0; i < 4; ++i) rg[i] = *(const u32x4*)(wsrc + (size_t)i * 64 * LDW + (k0)); \
                     _Pragma("unroll") for (int i = 0; i < 4; ++i) rg[4 + i] = *(const u32x4*)(xsrc + (size_t)i * 64 * LDX + (k0)); }
#define G_STORE() { _Pragma("unroll") for (int i = 0; i < 4; ++i) *(u32x4*)(lds + st_off + i * 64 * LROW) = rg[i]; \
                    _Pragma("unroll") for (int i = 0; i < 4; ++i) *(u32x4*)(lds + WT + st_off + i * 64 * LROW) = rg[4 + i]; }
  const int wfo = (wn * 64 + swz(r)) * LROW + 8 * h;
  const int xfo = WT + (wm * 128 + r) * LROW + 8 * h;
  constexpr int NK = D / BK;
#pragma unroll 1
  for (int pass = 0; pass < (EPI == EPI_AOUT ? 2 : 1); ++pass) {
  if (EPI == EPI_AOUT && pass == 1) {
    wsrc = p.WcT + (size_t)(tile_n * 256 + lrow) * D + lkc * 8; xsrc = p.conv + (size_t)(tile_m * 256 + lrow) * D + lkc * 8;
#pragma unroll
    for (int mb = 0; mb < 2; ++mb) {
      u32x4 ra[2][2][2], rc[2][2][2];
#pragma unroll
      for (int m2 = 0; m2 < 2; ++m2)
#pragma unroll
        for (int ni = 0; ni < 2; ++ni)
#pragma unroll
          for (int run = 0; run < 2; ++run) {
            const size_t off = (size_t)(tile_m * 256 + wm * 128 + (2 * mb + m2) * 32 + r) * D + 64 * gq_ + 32 * ni + 16 * run + 8 * h;
            ra[m2][ni][run] = *(const u32x4*)(p.sga + off); rc[m2][ni][run] = *(const u32x4*)(p.sgc + off);
          }
      __builtin_amdgcn_sched_barrier(0);
#pragma unroll
      for (int m2 = 0; m2 < 2; ++m2)
#pragma unroll
        for (int ni = 0; ni < 2; ++ni)
#pragma unroll
          for (int run = 0; run < 2; ++run)
#pragma unroll
            for (int j = 0; j < 4; ++j) {
              const unsigned wa = ra[m2][ni][run][j], wc = rc[m2][ni][run][j];
              acc[ni][2 * mb + m2][8 * run + 2 * j] *= bflo(wa) * __builtin_amdgcn_rcpf(fmaxf(bflo(wc), 1e-30f));
              acc[ni][2 * mb + m2][8 * run + 2 * j + 1] *= bfhi(wa) * __builtin_amdgcn_rcpf(fmaxf(bfhi(wc), 1e-30f));
            }
      __builtin_amdgcn_sched_barrier(0);
    }
  }
  G_LOAD(0);
#pragma unroll 1
  for (int kt = 0; kt < NK; ++kt) {
    G_STORE();
    __syncthreads();
    if (kt + 1 < NK) G_LOAD((kt + 1) * BK);
    __builtin_amdgcn_sched_barrier(0);
#pragma unroll
    for (int ks = 0; ks < 4; ++ks) {
      bf16x8 wf[2], xf[4];
#pragma unroll
      for (int ni = 0; ni < 2; ++ni) wf[ni] = *(const bf16x8*)(lds + wfo + ni * 32 * LROW + ks * 16);
#pragma unroll
      for (int mi = 0; mi < 4; ++mi) xf[mi] = *(const bf16x8*)(lds + xfo + mi * 32 * LROW + ks * 16);
      __builtin_amdgcn_s_setprio(1);
#pragma unroll
      for (int ni = 0; ni < 2; ++ni)
#pragma unroll
        for (int mi = 0; mi < 4; ++mi) acc[ni][mi] = __builtin_amdgcn_mfma_f32_32x32x16_bf16(wf[ni], xf[mi], acc[ni][mi], 0, 0, 0);
      __builtin_amdgcn_s_setprio(0);
    }
    __builtin_amdgcn_sched_barrier(0);
    __syncthreads();
  }
  }
#undef G_LOAD
#undef G_STORE

  const int g = tile_n * 4 + wn;
  bf16_t* const wlt = lds + (GBUF > 4 * ATILE ? GBUF : 4 * ATILE) + wid * STG;
  bf16_t* const wl = wlt + r * SROWE;
  if (EPI == EPI_INPROJ) {
    {
      float bz[2][16];
#pragma unroll
      for (int ni = 0; ni < 2; ++ni)
#pragma unroll
        for (int run = 0; run < 2; ++run) load8f(p.bias_v + 64 * g + 32 * ni + 16 * run + 8 * h, &bz[ni][8 * run]);
      __builtin_amdgcn_sched_barrier(0);
#pragma unroll
      for (int mi = 0; mi < 4; ++mi)
#pragma unroll
        for (int ni = 0; ni < 2; ++ni)
#pragma unroll
          for (int i = 0; i < 16; ++i) acc[ni][mi][i] += bz[ni][i];
    }
    if (g < 20) {
      const float* gain = g < 16 ? p.q_gain : p.k_gain;
      const float osc = g < 16 ? QSCALE : 1.0f;
      float gn[2][16];
#pragma unroll
      for (int ni = 0; ni < 2; ++ni) { load8f(gain + 32 * ni + 8 * h, &gn[ni][0]); load8f(gain + 32 * ni + 16 + 8 * h, &gn[ni][8]); }
#pragma unroll
      for (int mi = 0; mi < 4; ++mi) {
        const int tl = tile_m * 256 + wm * 128 + mi * 32 + r, t = tl & (S - 1);
        float cs[2][8], sn[2][8];
#pragma unroll
        for (int ni = 0; ni < 2; ++ni) { const int pos = ni ? (t & 63) : (t >> 6); load8f(p.tab_cos + pos * 16 + 8 * h, cs[ni]); load8f(p.tab_sin + pos * 16 + 8 * h, sn[ni]); }
        float ss = 0.f;
#pragma unroll
        for (int ni = 0; ni < 2; ++ni)
#pragma unroll
          for (int i = 0; i < 16; ++i) ss += acc[ni][mi][i] * acc[ni][mi][i];
        ss += __shfl_xor(ss, 32);
        const float rinv = rsqrtf(ss * (1.0f / 64.0f) + 1e-6f);
        const int tl0 = tile_m * 256 + wm * 128 + mi * 32;
        bf16_t* dst0 = g < 16 ? p.Q + (size_t)tl0 * D + 64 * g : p.Kb + (size_t)tl0 * 256 + 64 * (g - 16);
#pragma unroll
        for (int ni = 0; ni < 2; ++ni) {
          float o1[8], o2[8];
#pragma unroll
          for (int j = 0; j < 8; ++j) {
            const float a = acc[ni][mi][j] * rinv * gn[ni][j], b = acc[ni][mi][8 + j] * rinv * gn[ni][8 + j];
            o1[j] = (a * cs[ni][j] - b * sn[ni][j]) * osc; o2[j] = (b * cs[ni][j] + a * sn[ni][j]) * osc;
          }
          store8(wl + 32 * ni + 8 * h, o1); store8(wl + 32 * ni + 16 + 8 * h, o2);
        }
        flush_rows<8>(wlt, dst0, g < 16 ? D : 256, lane);
      }
    } else {
#pragma unroll
      for (int mi = 0; mi < 4; ++mi) {
        const int tl = tile_m * 256 + wm * 128 + mi * 32 + r;
        if (g < 24) {
          const int kvh = g - 20, sl = tl / S, t = tl & (S - 1);
          bf16_t* dst = p.Vt + (size_t)((sl * 4 + kvh) * 64) * S + t;
#pragma unroll
          for (int ni = 0; ni < 2; ++ni)
#pragma unroll
            for (int i = 0; i < 16; ++i) {
              const int d = 32 * ni + (i & 7) + 8 * h + 16 * (i >> 3);
              dst[(size_t)d * S] = (bf16_t)(pk2(acc[ni][mi][i], 0.f) & 0xffffu);
            }
        } else if (g < 40) {
          bf16_t* dst0 = p.sza + (size_t)(tl - r) * D + 64 * (g - 24);
#pragma unroll
          for (int ni = 0; ni < 2; ++ni)
#pragma unroll
            for (int run = 0; run < 2; ++run) {
              float o[8];
#pragma unroll
              for (int j = 0; j < 8; ++j) o[j] = siluf_(acc[ni][mi][8 * run + j]);
              store8(wl + 32 * ni + 16 * run + 8 * h, o);
            }
          flush_rows<8>(wlt, dst0, D, lane);
        } else if (g < 104) {
          const bool isU = g < 72;
          bf16_t* dst0 = (isU ? p.U + 32 * (g - 40) : p.G + 32 * (g - 72)) + (size_t)(tl - r) * D;
#pragma unroll
          for (int run = 0; run < 2; ++run) {
            float o[8];
#pragma unroll
            for (int j = 0; j < 8; ++j) o[j] = isU ? acc[0][mi][8 * run + j] * acc[1][mi][8 * run + j] : acc[0][mi][8 * run + j] * siluf_(acc[1][mi][8 * run + j]);
            store8(wl + 16 * run + 8 * h, o);
          }
          flush_rows<4>(wlt, dst0, D, lane);
        } else {
          bf16_t* dst0 = (g < 120 ? p.sga + 64 * (g - 104) : p.sgc + 64 * (g - 120)) + (size_t)(tl - r) * D;
#pragma unroll
          for (int ni = 0; ni < 2; ++ni)
#pragma unroll
            for (int run = 0; run < 2; ++run) {
              float o[8];
#pragma unroll
              for (int j = 0; j < 8; ++j) o[j] = sigmoidf_(acc[ni][mi][8 * run + j]);
              store8(wl + 32 * ni + 16 * run + 8 * h, o);
            }
          flush_rows<8>(wlt, dst0, D, lane);
        }
      }
    }
  }
  if (EPI == EPI_AOUT) {
    u32x4 rc[4][2][2];
#pragma unroll
    for (int mi = 0; mi < 4; ++mi)
#pragma unroll
      for (int ni = 0; ni < 2; ++ni)
#pragma unroll
        for (int run = 0; run < 2; ++run)
          rc[mi][ni][run] = *(const u32x4*)(p.sgc + (size_t)(tile_m * 256 + wm * 128 + mi * 32 + r) * D + 64 * g + 32 * ni + 16 * run + 8 * h);
    __builtin_amdgcn_sched_barrier(0);
#pragma unroll
    for (int mi = 0; mi < 4; ++mi)
#pragma unroll
      for (int ni = 0; ni < 2; ++ni)
#pragma unroll
        for (int run = 0; run < 2; ++run) {
          float o[8];
#pragma unroll
          for (int j = 0; j < 4; ++j) { const unsigned wc = rc[mi][ni][run][j]; o[2 * j] = acc[ni][mi][8 * run + 2 * j] * bflo(wc); o[2 * j + 1] = acc[ni][mi][8 * run + 2 * j + 1] * bfhi(wc); }
          store8(p.G + (size_t)(tile_m * 256 + wm * 128 + mi * 32 + r) * D + 64 * g + 32 * ni + 16 * run + 8 * h, o);
        }
  }
  if (EPI == EPI_OUT) {
#pragma unroll
    for (int mb = 0; mb < 2; ++mb) {
      f32x4 xr[2][2][2][2];
#pragma unroll
      for (int m2 = 0; m2 < 2; ++m2)
#pragma unroll
        for (int ni = 0; ni < 2; ++ni)
#pragma unroll
          for (int run = 0; run < 2; ++run) {
            const int tl = tile_m * 256 + wm * 128 + (2 * mb + m2) * 32 + r;
            const float* xp_ = xrow(p, row0 + tl) + 64 * g + 32 * ni + 16 * run + 8 * h;
            xr[m2][ni][run][0] = *(const f32x4*)xp_; xr[m2][ni][run][1] = *(const f32x4*)(xp_ + 4);
          }
      __builtin_amdgcn_sched_barrier(0);
#pragma unroll
      for (int m2 = 0; m2 < 2; ++m2)
#pragma unroll
        for (int ni = 0; ni < 2; ++ni)
#pragma unroll
          for (int run = 0; run < 2; ++run) {
            const int mi = 2 * mb + m2, tl = tile_m * 256 + wm * 128 + mi * 32 + r;
            float* dst = p.out + (size_t)(row0 + tl) * D + 64 * g + 32 * ni + 16 * run + 8 * h;
            f32x4 a, b;
#pragma unroll
            for (int j = 0; j < 4; ++j) { a[j] = DN_ALPHA * xr[m2][ni][run][0][j] + acc[ni][mi][8 * run + j]; b[j] = DN_ALPHA * xr[m2][ni][run][1][j] + acc[ni][mi][8 * run + 4 + j]; }
            *(f32x4*)dst = a; *(f32x4*)(dst + 4) = b;
          }
      __builtin_amdgcn_sched_barrier(0);
    }
  }
}

__device__ void phase_conv(const Params& p, int S, int nrows) {
  const int gt = BID * NTHR + TID, gn = gridDim.x * NTHR;
  for (int i = gt; i < (nrows >> 2) * 128; i += gn) {
    const int tl0 = (i >> 7) * 4, c8 = (i & 127) * 8, t0 = tl0 & (S - 1);
    float u[6][8], gg[4][8], w0[8], w1[8], w2[8], b[8];
    const bf16_t* up_ = p.U + (size_t)tl0 * D + c8;
    if (t0 > 0) load8(up_ - D, u[0]); else {
#pragma unroll
      for (int j = 0; j < 8; ++j) u[0][j] = 0.f; }
#pragma unroll
    for (int k = 0; k < 4; ++k) load8(up_ + (size_t)k * D, u[k + 1]);
    if (t0 + 4 < S) load8(up_ + (size_t)4 * D, u[5]); else {
#pragma unroll
      for (int j = 0; j < 8; ++j) u[5][j] = 0.f; }
#pragma unroll
    for (int k = 0; k < 4; ++k) load8(p.G + (size_t)(tl0 + k) * D + c8, gg[k]);
    load8f(p.conv_w + c8, w0); load8f(p.conv_w + D + c8, w1); load8f(p.conv_w + 2 * D + c8, w2); load8f(p.conv_b + c8, b);
#pragma unroll
    for (int k = 0; k < 4; ++k) {
      float o[8];
#pragma unroll
      for (int j = 0; j < 8; ++j) o[j] = gg[k][j] * (w0[j] * u[k][j] + w1[j] * u[k + 1][j] + w2[j] * u[k + 2][j] + b[j]);
      store8(p.conv + (size_t)(tl0 + k) * D + c8, o);
    }
  }
}

__device__ void attn_unit(const Params& p, int S, int unit, bf16_t* lds) {
  const int tid = TID, lane = tid & 63, wid = tid >> 6, r = lane & 31, h = lane >> 5;
  const int nqb = S >> 9;
  const int qb = unit % nqb, hq4 = (unit / nqb) & 3, kvh = (unit / (4 * nqb)) & 3, sl = unit / (16 * nqb);
  const int head = kvh * 4 + hq4;
  float gq = fabsf(p.q_gain[lane]), gk = fabsf(p.k_gain[lane]);
#pragma unroll
  for (int o = 32; o > 0; o >>= 1) { gq = fmaxf(gq, __shfl_xor(gq, o)); gk = fmaxf(gk, __shfl_xor(gk, o)); }
  const float negM = -(64.0f * gq * gk * QSCALE * 1.02f);
  const int tq = sl * S + qb * 512 + wid * 64 + r;
  bf16x8 qf[2][4];
#pragma unroll
  for (int q2 = 0; q2 < 2; ++q2)
#pragma unroll
    for (int st = 0; st < 4; ++st) qf[q2][st] = *(const bf16x8*)(p.Q + (size_t)(tq + 32 * q2) * D + head * 64 + 16 * st + 8 * h);
  const bf16_t* Kg = p.Kb + (size_t)(sl * S) * 256 + kvh * 64;
  const bf16_t* Vg = p.Vt + (size_t)((sl * 4 + kvh) * 64) * S;
  const int lr = tid >> 3, lc = (tid & 7) * 8;
  const bf16_t* ksrc = Kg + (size_t)lr * 256 + lc;
  const bf16_t* vsrc = Vg + (size_t)lr * S + lc;
  const int st_off = lr * AROW + lc;
  u32x4 ta[2];
#define A_LOAD(R, kk) { const size_t kk_ = (size_t)(kk); R[0] = *(const u32x4*)(ksrc + kk_ * 256); R[1] = *(const u32x4*)(vsrc + kk_); }
#define A_STORE(R, buf) { bf16_t* sb_ = lds + (buf) * 2 * ATILE; *(u32x4*)(sb_ + st_off) = R[0]; *(u32x4*)(sb_ + ATILE + st_off) = R[1]; }
  f32x16 o[2][2];
#pragma unroll
  for (int a = 0; a < 2; ++a)
#pragma unroll
    for (int b = 0; b < 2; ++b)
#pragma unroll
      for (int i = 0; i < 16; ++i) o[a][b][i] = 0.f;
  float ls[2] = {0.f, 0.f};
  const int fo = swz(r) * AROW + 8 * h;
  const int nt = S >> 6;
#define A_COMPUTE(buf) { const bf16_t* kb_ = lds + (buf) * 2 * ATILE; const bf16_t* vb_ = kb_ + ATILE; \
    _Pragma("unroll") for (int kb = 0; kb < 2; ++kb) { \
      __builtin_amdgcn_sched_barrier(0); \
      bf16x8 kf[4], vf[2][2]; \
      _Pragma("unroll") for (int st = 0; st < 4; ++st) kf[st] = *(const bf16x8*)(kb_ + fo + kb * 32 * AROW + 16 * st); \
      _Pragma("unroll") for (int sp = 0; sp < 2; ++sp) _Pragma("unroll") for (int dt = 0; dt < 2; ++dt) vf[sp][dt] = *(const bf16x8*)(vb_ + fo + dt * 32 * AROW + kb * 32 + sp * 16); \
      f32x16 sx[2]; \
      _Pragma("unroll") for (int q2 = 0; q2 < 2; ++q2) _Pragma("unroll") for (int i = 0; i < 16; ++i) sx[q2][i] = negM; \
      __builtin_amdgcn_s_setprio(1); \
      _Pragma("unroll") for (int st = 0; st < 4; ++st) _Pragma("unroll") for (int q2 = 0; q2 < 2; ++q2) sx[q2] = __builtin_amdgcn_mfma_f32_32x32x16_bf16(kf[st], qf[q2][st], sx[q2], 0, 0, 0); \
      __builtin_amdgcn_s_setprio(0); \
      bf16x8 pf[2][2]; \
      _Pragma("unroll") for (int q2 = 0; q2 < 2; ++q2) { \
        _Pragma("unroll") for (int i = 0; i < 16; ++i) { sx[q2][i] = __builtin_amdgcn_exp2f(sx[q2][i]); ls[q2] += sx[q2][i]; } \
        _Pragma("unroll") for (int sp = 0; sp < 2; ++sp) { u32x4 pw; \
          pw.x = pk2(sx[q2][8 * sp + 0], sx[q2][8 * sp + 1]); pw.y = pk2(sx[q2][8 * sp + 2], sx[q2][8 * sp + 3]); \
          pw.z = pk2(sx[q2][8 * sp + 4], sx[q2][8 * sp + 5]); pw.w = pk2(sx[q2][8 * sp + 6], sx[q2][8 * sp + 7]); \
          pf[q2][sp] = __builtin_bit_cast(bf16x8, pw); } } \
      __builtin_amdgcn_s_setprio(1); \
      _Pragma("unroll") for (int sp = 0; sp < 2; ++sp) _Pragma("unroll") for (int dt = 0; dt < 2; ++dt) _Pragma("unroll") for (int q2 = 0; q2 < 2; ++q2) \
        o[q2][dt] = __builtin_amdgcn_mfma_f32_32x32x16_bf16(vf[sp][dt], pf[q2][sp], o[q2][dt], 0, 0, 0); \
      __builtin_amdgcn_s_setprio(0); } }
  A_LOAD(ta, 0);
  A_STORE(ta, 0);
  __syncthreads();
#pragma unroll 1
  for (int it = 0; it < nt; ++it) {
    const bool more = it + 1 < nt;
    if (more) A_LOAD(ta, (it + 1) * 64);
    __builtin_amdgcn_sched_barrier(0);
    const int bsel = it & 1;
    A_COMPUTE(bsel);
    __builtin_amdgcn_sched_barrier(0);
    if (more) A_STORE(ta, bsel ^ 1);
    __syncthreads();
  }
#undef A_LOAD
#undef A_STORE
#undef A_COMPUTE
  u32x4 zr[2][2][2];
#pragma unroll
  for (int q2 = 0; q2 < 2; ++q2)
#pragma unroll
    for (int dt = 0; dt < 2; ++dt)
#pragma unroll
      for (int run = 0; run < 2; ++run) zr[q2][dt][run] = *(const u32x4*)(p.sza + (size_t)(tq + 32 * q2) * D + head * 64 + 32 * dt + 16 * run + 8 * h);
  __builtin_amdgcn_sched_barrier(0);
#pragma unroll
  for (int q2 = 0; q2 < 2; ++q2) {
    float lsum = ls[q2];
    lsum += __shfl_xor(lsum, 32);
    const float inv = __frcp_rn(lsum);
#pragma unroll
    for (int dt = 0; dt < 2; ++dt)
#pragma unroll
      for (int run = 0; run < 2; ++run) {
        const size_t off = (size_t)(tq + 32 * q2) * D + head * 64 + 32 * dt + 16 * run + 8 * h;
        float w[8];
#pragma unroll
        for (int j = 0; j < 4; ++j) { const unsigned z = zr[q2][dt][run][j]; w[2 * j] = o[q2][dt][8 * run + 2 * j] * inv * bflo(z); w[2 * j + 1] = o[q2][dt][8 * run + 2 * j + 1] * inv * bfhi(z); }
        store8(p.Q + off, w);
      }
  }
}

__device__ void phase_ln(const Params& p, int row0, int nrows) {
  const int tid = TID, lane = tid & 63, wid = tid >> 6;
  f32x4 gg[4], bb[4];
#pragma unroll
  for (int i = 0; i < 4; ++i) { gg[i] = *(const f32x4*)(p.ln_g + i * 256 + lane * 4); bb[i] = *(const f32x4*)(p.ln_b + i * 256 + lane * 4); }
  constexpr int LNR = 4;
  for (int rr = (BID * (NTHR / 64) + wid) * LNR; rr < nrows; rr += gridDim.x * (NTHR / 64) * LNR) {
    float* row = p.out + (size_t)(row0 + rr) * D;
    f32x4 v[LNR][4];
    float s[LNR];
#pragma unroll
    for (int u = 0; u < LNR; ++u) s[u] = 0.f;
#pragma unroll
    for (int u = 0; u < LNR; ++u)
#pragma unroll
      for (int i = 0; i < 4; ++i) { v[u][i] = __builtin_nontemporal_load((const f32x4*)(row + u * D + i * 256 + lane * 4)); s[u] += (v[u][i].x + v[u][i].y) + (v[u][i].z + v[u][i].w); }
#pragma unroll
    for (int o = 32; o > 0; o >>= 1) {
#pragma unroll
      for (int u = 0; u < LNR; ++u) s[u] += __shfl_xor(s[u], o); }
#pragma unroll
    for (int u = 0; u < LNR; ++u) {
      const float mu = s[u] * (1.0f / D);
      float q = 0.f;
#pragma unroll
      for (int i = 0; i < 4; ++i) { v[u][i] = v[u][i] - mu; q += (v[u][i].x * v[u][i].x + v[u][i].y * v[u][i].y) + (v[u][i].z * v[u][i].z + v[u][i].w * v[u][i].w); }
#pragma unroll
      for (int o = 32; o > 0; o >>= 1) q += __shfl_xor(q, o);
      const float rstd = rsqrtf(q * (1.0f / D) + 1e-5f);
#pragma unroll
      for (int i = 0; i < 4; ++i) __builtin_nontemporal_store(v[u][i] * rstd * gg[i] + bb[i], (f32x4*)(row + u * D + i * 256 + lane * 4));
    }
  }
}

#define XB_TMO      128
#define XB_XCNT(j)  (256  + 64 * (j))
#define XB_XSUB(j)  (1280 + 64 * (j))
#define XB_XGEN(j)  (2304 + 64 * (j))
#define XB_TOP      3328
#define XB_TOPGEN   3392
#define XCD_BAR_WORDS 3456
#define XB_SPIN_CAP (1u << 22)
DI unsigned xb_ld(unsigned* p) { return __hip_atomic_load(p, __ATOMIC_RELAXED, __HIP_MEMORY_SCOPE_AGENT); }
DI unsigned xb_add(unsigned* p, unsigned v) { return __hip_atomic_fetch_add(p, v, __ATOMIC_RELAXED, __HIP_MEMORY_SCOPE_AGENT); }
DI unsigned xb_xcc_id() { return (unsigned)__builtin_amdgcn_s_getreg((3 << 11) | 20) & 0xFu; }
#define XB_SPIN(cond, bar) do { unsigned _sp = 0; while (cond) { __builtin_amdgcn_s_sleep(1); \
    if ((++_sp & 255u) == 0u) { if (xb_ld(&(bar)[XB_TMO])) break; if (_sp > XB_SPIN_CAP) { atomicAdd(&(bar)[XB_TMO], 1u); break; } } } } while (0)
DI void xcd_barrier_complete(unsigned* bar, unsigned x, unsigned& nloc, unsigned& nx) {
  const unsigned G = gridDim.x;
  unsigned sum, cnt, mine, sp = 0u;
  for (;;) {
    sum = 0u; cnt = 0u; mine = 0u;
#pragma unroll
    for (unsigned j = 0; j < 16; ++j) { const unsigned c = xb_ld(&bar[XB_XCNT(j)]); sum += c; cnt += (c > 0u) ? 1u : 0u; mine = (j == x) ? c : mine; }
    if (sum == G) break;
    __builtin_amdgcn_s_sleep(1);
    if ((++sp & 255u) == 0u) { if (xb_ld(&bar[XB_TMO])) break; if (sp > XB_SPIN_CAP) { atomicAdd(&bar[XB_TMO], 1u); break; } }
  }
  nloc = mine > 0u ? mine : 1u; nx = cnt > 0u ? cnt : 1u;
}
#define LAS __attribute__((address_space(3)))
DI void xcd_barrier(unsigned* bar, unsigned x, volatile LAS unsigned* st) {
  asm volatile("s_waitcnt vmcnt(0)" ::: "memory");
  __syncthreads();
  if (threadIdx.x == 0) {
    __builtin_amdgcn_s_waitcnt(0);
    unsigned nloc = st[0], nx = st[1];
    if (nloc == 0u) { xcd_barrier_complete(bar, x, nloc, nx); st[0] = nloc; st[1] = nx; }
    const unsigned old = xb_add(&bar[XB_XSUB(x)], 1u);
    const unsigned gen = old / nloc;
    if (old + 1u == (gen + 1u) * nloc) {
      __builtin_amdgcn_fence(__ATOMIC_RELEASE, "agent");
      asm volatile("s_waitcnt vmcnt(0)" ::: "memory");
      const unsigned og = xb_add(&bar[XB_TOP], 1u);
      const unsigned tg = og / nx;
      if (og + 1u == (tg + 1u) * nx) xb_add(&bar[XB_TOPGEN], 1u);
      else XB_SPIN(xb_ld(&bar[XB_TOPGEN]) == tg, bar);
      __builtin_amdgcn_fence(__ATOMIC_ACQUIRE, "agent");
      xb_add(&bar[XB_XGEN(x)], 1u);
      asm volatile("s_waitcnt vmcnt(0)" ::: "memory");
    } else {
      XB_SPIN(xb_ld(&bar[XB_XGEN(x)]) == gen, bar);
      __builtin_amdgcn_fence(__ATOMIC_ACQUIRE, "agent");
      asm volatile("s_waitcnt vmcnt(0)" ::: "memory");
    }
  }
  __syncthreads();
}

__device__ void run_phase(const Params& p, int ph, bf16_t* lds) {
  if (ph == 0) { phase_prep(p, lds); return; }
  if (ph == NPHASE - 1) { phase_ln(p, 16384, 32768); return; }
  const int c = (ph - 1) / 4, sub = (ph - 1) % 4, row0 = c ? 16384 : 0, nrows = c ? 32768 : 16384, S = c ? 4096 : 16384;
  const int lgmx = c ? 4 : 3, MX = 1 << lgmx, MT = 8 * MX;
  if (sub == 0) {
    const bf16_t* X = p.xb + (size_t)row0 * PX;
    for (int id = BID; id < 34 * MT; id += gridDim.x) {
      const int xcd = id & 7, j = id >> 3, n = j >> lgmx, m = MX * xcd + (j & (MX - 1));
      gemm_tile<EPI_INPROJ>(p, p.WinT, X, n, m, row0, S, lds);
    }
    if (c > 0) phase_ln(p, 0, 16384);
    else {
      const int G = gridDim.x, rem = (34 * MT) % G, b = BID;
      if (rem == 0) convert_x(p, 16384, T_ALL, b, G);
      else if (b >= rem) convert_x(p, 16384, T_ALL, b - rem, G - rem);
    }
  } else if (sub == 1) {
    const int nunits = nrows >> 5, UX = nunits >> 3;
    const bool conv_first = ((BID >> 3) & 1) != 0;
    if (conv_first) phase_conv(p, S, nrows);
    for (int id = BID; id < nunits; id += gridDim.x) attn_unit(p, S, UX * (id & 7) + (id >> 3), lds);
    if (!conv_first) phase_conv(p, S, nrows);
  } else if (sub == 2) {
    for (int id = BID; id < 4 * MT; id += gridDim.x) { const int j = id >> 3; gemm_tile<EPI_AOUT>(p, p.WaT, p.Q, j & 3, MX * (id & 7) + (j >> 2), row0, S, lds); }
  } else {
    for (int id = BID; id < 4 * MT; id += gridDim.x) { const int j = id >> 3; gemm_tile<EPI_OUT>(p, p.WoT, p.G, j & 3, MX * (id & 7) + (j >> 2), row0, S, lds); }
  }
}

__global__ void __launch_bounds__(NTHR, 2) mega(Params p, int ph_begin, int ph_end) {
  __shared__ __attribute__((aligned(16))) bf16_t lds[LDS_ELEMS];
  __shared__ uint4 xb_words;
  if (threadIdx.x == 0) xb_words = make_uint4(0u, 0u, 0u, 0u);
  __syncthreads();
  const unsigned xcc = xb_xcc_id();
  if (threadIdx.x == 0 && ph_end - ph_begin > 1) (void)xb_add(&p.bar[XB_XCNT(xcc)], 1u);
  if (ph_begin < 0) cg::this_grid().sync();
  for (int ph = ph_begin; ph < ph_end; ++ph) {
    run_phase(p, ph, lds);
    if (ph + 1 < ph_end) xcd_barrier(p.bar, xcc, (volatile LAS unsigned*)&xb_words);
  }
}

extern "C" void kernel_launch(void* const* d_in, const int* in_sizes, int n_in, void* d_out, int out_size, void* d_ws, size_t ws_size, hipStream_t stream) {
  static int grid_blocks = 0;
  if (!grid_blocks) {
    int dev = 0, cus = 0, per_cu = 0;
    hipGetDevice(&dev);
    hipDeviceGetAttribute(&cus, hipDeviceAttributeMultiprocessorCount, dev);
    hipOccupancyMaxActiveBlocksPerMultiprocessor(&per_cu, mega, NTHR, 0);
    if (per_cu > 1) per_cu = 1;
    if (per_cu < 1) per_cu = 1;
    if (per_cu > 4) per_cu = 4;
    grid_blocks = cus * per_cu;
  }
  Params p{};
  p.xp = (const float*)d_in[0]; p.xs = (const float*)d_in[1]; p.w_in = (const float*)d_in[2]; p.b_in = (const float*)d_in[3];
  p.q_gain = (const float*)d_in[4]; p.k_gain = (const float*)d_in[5]; p.conv_w = (const float*)d_in[6]; p.conv_b = (const float*)d_in[7];
  p.w_attn_out = (const float*)d_in[8]; p.w_conv_out = (const float*)d_in[9]; p.w_o = (const float*)d_in[10];
  p.ln_g = (const float*)d_in[11]; p.ln_b = (const float*)d_in[12];
  p.out = (float*)d_out;
  char* w = (char*)d_ws; size_t off = 0;
  auto take = [&](size_t bytes) { char* q = w + off; off += (bytes + 255) & ~(size_t)255; return q; };
  p.WinT = (bf16_t*)take((size_t)INW * PX * 2);
  p.WaT = (bf16_t*)take((size_t)D * D * 2); p.WcT = (bf16_t*)take((size_t)D * D * 2); p.WoT = (bf16_t*)take((size_t)D * D * 2);
  p.bias_v = (float*)take(INW * 4); p.tab_cos = (float*)take(256 * 16 * 4); p.tab_sin = (float*)take(256 * 16 * 4);
  p.xb = (bf16_t*)take((size_t)T_ALL * PX * 2);
  p.Q = (bf16_t*)take((size_t)CHMAX * D * 2); p.Kb = (bf16_t*)take((size_t)CHMAX * 256 * 2); p.Vt = (bf16_t*)take((size_t)CHMAX * 256 * 2);
  p.sza = (bf16_t*)take((size_t)CHMAX * D * 2); p.U = (bf16_t*)take((size_t)CHMAX * D * 2); p.G = (bf16_t*)take((size_t)CHMAX * D * 2);
  p.sga = (bf16_t*)take((size_t)CHMAX * D * 2); p.sgc = (bf16_t*)take((size_t)CHMAX * D * 2); p.conv = (bf16_t*)take((size_t)CHMAX * D * 2);
  p.mc = p.sgc;
  p.bar = (unsigned*)take(XCD_BAR_WORDS * 4);
  if (off > ws_size) { fprintf(stderr, "workspace too small: need %zu have %zu\n", off, ws_size); return; }
#if MK_SINGLE
  hipMemsetAsync(p.bar, 0, XCD_BAR_WORDS * 4, stream);
  int b = 0, e = NPHASE;
  void* args[] = {&p, &b, &e};
  hipError_t err = hipLaunchCooperativeKernel((void*)mega, dim3(grid_blocks), dim3(NTHR), args, 0, stream);
  if (err != hipSuccess) fprintf(stderr, "cooperative launch failed: %s (grid %d)\n", hipGetErrorString(err), grid_blocks);
#else
  for (int ph = 0; ph < NPHASE; ++ph) hipLaunchKernelGGL(mega, dim3(grid_blocks), dim3(NTHR), 0, stream, p, ph, ph + 1);
#endif
}
```

```cpp
#include <hip/hip_runtime.h>
#include <hip/hip_cooperative_groups.h>
#include <cstdio>
#include <cstdint>
namespace cg = cooperative_groups;

#ifndef ATT_C
#define ATT_C 1.0f
#endif
#ifndef OSC
#define OSC 1.0f
#endif
#ifndef MK_SINGLE
#define MK_SINGLE 1
#endif

typedef unsigned short bf16_t;
typedef short bf16x8 __attribute__((ext_vector_type(8)));
typedef float f32x16 __attribute__((ext_vector_type(16)));
typedef float f32x4 __attribute__((ext_vector_type(4)));
typedef float f32x2 __attribute__((ext_vector_type(2)));
typedef unsigned u32x4 __attribute__((ext_vector_type(4)));
typedef __bf16 bf16x2_t __attribute__((ext_vector_type(2)));
#define DI __device__ __forceinline__
DI int opq_v(int t) { asm volatile("" : "+v"(t)); return t; }
DI int opq_s(int t) { asm volatile("" : "+s"(t)); return t; }
#define TID (opq_v((int)threadIdx.x))
#define BID (opq_s((int)blockIdx.x))

constexpr int D = 1024, INW = 8704, T_ALL = 49152, CHMAX = 32768;
constexpr int BK = 64, LROW = BK + 8, WT = 256 * LROW, XT = 256 * LROW, GBUF = WT + XT;
constexpr int AROW = 72, ATILE = 64 * AROW;
constexpr int SROWE = 72, STG = 32 * SROWE;
constexpr int LDS_ELEMS = (GBUF > 4 * ATILE ? GBUF : 4 * ATILE) + 8 * STG;
constexpr float QSCALE = 0.125f * 1.4426950408889634f;
constexpr float DN_ALPHA = 1.189207115002721f;
constexpr int NPHASE = 10;
constexpr int NTHR = 512;
constexpr int PX = 1088;

struct Params {
  const float* xp; const float* xs; const float* w_in; const float* b_in; const float* q_gain; const float* k_gain;
  const float* conv_w; const float* conv_b; const float* w_attn_out; const float* w_conv_out; const float* w_o;
  const float* ln_g; const float* ln_b;
  float* out;
  bf16_t* WinT; bf16_t* WaT; bf16_t* WcT; bf16_t* WoT; float* bias_v; float* tab_cos; float* tab_sin;
  bf16_t* xb; bf16_t* Q; bf16_t* Kb; bf16_t* Vt; bf16_t* sza; bf16_t* U; bf16_t* G; bf16_t* sga; bf16_t* sgc; bf16_t* conv; bf16_t* mc;
  unsigned* bar;
};

DI unsigned pk2(float lo, float hi) { f32x2 v = {lo, hi}; return __builtin_bit_cast(unsigned, __builtin_convertvector(v, bf16x2_t)); }
DI float bf2f(unsigned short x) { return __uint_as_float(((unsigned)x) << 16); }
DI float bflo(unsigned w) { return __uint_as_float(w << 16); }
DI float bfhi(unsigned w) { return __uint_as_float(w & 0xffff0000u); }
DI int swz(int r) { return (r & ~12) | ((r & 4) << 1) | ((r & 8) >> 1); }
DI float sigmoidf_(float z) { return __frcp_rn(1.0f + __expf(-z)); }
DI float siluf_(float z) { return z * sigmoidf_(z); }
DI void store8(bf16_t* dst, const float* v) {
  u32x4 w; w.x = pk2(v[0], v[1]); w.y = pk2(v[2], v[3]); w.z = pk2(v[4], v[5]); w.w = pk2(v[6], v[7]);
  *(u32x4*)dst = w;
}
DI void load8(const bf16_t* src, float* v) {
  u32x4 w = *(const u32x4*)src;
  v[0] = bflo(w.x); v[1] = bfhi(w.x); v[2] = bflo(w.y); v[3] = bfhi(w.y); v[4] = bflo(w.z); v[5] = bfhi(w.z); v[6] = bflo(w.w); v[7] = bfhi(w.w);
}
DI void load8f_nt(const float* src, float* v) {
  f32x4 a = __builtin_nontemporal_load((const f32x4*)src), b = __builtin_nontemporal_load((const f32x4*)(src + 4));
  v[0] = a.x; v[1] = a.y; v[2] = a.z; v[3] = a.w; v[4] = b.x; v[5] = b.y; v[6] = b.z; v[7] = b.w;
}
DI void load8f(const float* src, float* v) {
  f32x4 a = *(const f32x4*)src, b = *(const f32x4*)(src + 4);
  v[0] = a.x; v[1] = a.y; v[2] = a.z; v[3] = a.w; v[4] = b.x; v[5] = b.y; v[6] = b.z; v[7] = b.w;
}
DI int vcol(int v) {
  const int g = v >> 6, ni = (v >> 5) & 1, f = v & 31;
  if (g >= 40 && g < 72) { const int cb = g - 40; return (ni ? 4608 : 3584) + 32 * cb + f; }
  if (g >= 72 && g < 104) { const int cb = g - 72; return (ni ? 5632 : 2560) + 32 * cb + f; }
  return v;
}
DI const float* xrow(const Params& p, int R) { return R < 16384 ? p.xp + (size_t)R * D : p.xs + (size_t)(R - 16384) * D; }

__device__ void convert_x(const Params& p, int r0, int r1, int bidx, int nblk) {
  const int gt = bidx * NTHR + TID, gn = nblk * NTHR, i0 = r0 * (D / 8), i1 = r1 * (D / 8);
  for (int i = i0 + gt; i < i1; i += 4 * gn) {
    float v[4][8];
#pragma unroll
    for (int u = 0; u < 4; ++u) { const int ii = i + u * gn; if (ii < i1) load8f_nt(xrow(p, ii >> 7) + (ii & 127) * 8, v[u]); }
#pragma unroll
    for (int u = 0; u < 4; ++u) { const int ii = i + u * gn; if (ii < i1) store8(p.xb + (size_t)(ii >> 7) * PX + (ii & 127) * 8, v[u]); }
  }
}

__device__ void convert_x_queue(const Params& p, bf16_t* lds) {
  volatile int* slot = (volatile int*)lds;
  const int tid = TID;
  constexpr int RPI = 32, NITEM = 32768 / RPI;
  for (;;) {
    __syncthreads();
    if (tid == 0) *slot = (int)atomicAdd(p.bar + 64, 1u);
    __syncthreads();
    const int item = *slot;
    if (item >= NITEM) break;
    const int base = (16384 + item * RPI) * (D / 8);
#pragma unroll
    for (int hf = 0; hf < 2; ++hf) {
      float v[4][8];
#pragma unroll
      for (int u = 0; u < 4; ++u) { const int ii = base + hf * 2048 + u * 512 + tid; load8f_nt(xrow(p, ii >> 7) + (ii & 127) * 8, v[u]); }
#pragma unroll
      for (int u = 0; u < 4; ++u) { const int ii = base + hf * 2048 + u * 512 + tid; store8(p.xb + (size_t)(ii >> 7) * PX + (ii & 127) * 8, v[u]); }
    }
  }
}

__device__ void transpose_w(const float* __restrict__ src, int ldsrc, bf16_t* __restrict__ dst, int lddst, int ng32, bool virt, bf16_t* lds) {
  const int tid = TID;
  constexpr int TP = 136;
  for (int tile = BID; tile < ng32 * 8; tile += gridDim.x) {
    const int cgp = tile % ng32, kb = tile / ng32, v0 = cgp * 32, col0 = virt ? vcol(v0) : v0, k0 = kb * 128;
    f32x4 x[2];
#pragma unroll
    for (int ps = 0; ps < 2; ++ps) x[ps] = __builtin_nontemporal_load((const f32x4*)(src + (size_t)(k0 + ps * 64 + (tid >> 3)) * ldsrc + col0 + (tid & 7) * 4));
#pragma unroll
    for (int ps = 0; ps < 2; ++ps)
#pragma unroll
      for (int j = 0; j < 4; ++j) lds[((tid & 7) * 4 + j) * TP + ps * 64 + (tid >> 3)] = (bf16_t)(pk2(x[ps][j], 0.f) & 0xffffu);
    __syncthreads();
    const u32x4 w = *(const u32x4*)(lds + (tid >> 4) * TP + (tid & 15) * 8);
    *(u32x4*)(dst + (size_t)(v0 + (tid >> 4)) * lddst + k0 + (tid & 15) * 8) = w;
    __syncthreads();
  }
}

__device__ void phase_prep(const Params& p, bf16_t* lds) {
  const int gt = BID * NTHR + TID, gn = gridDim.x * NTHR;
  convert_x(p, 0, 16384, BID, gridDim.x);
  transpose_w(p.w_in, INW, p.WinT, PX, INW / 32, true, lds);
  transpose_w(p.w_attn_out, D, p.WaT, D, D / 32, false, lds);
  transpose_w(p.w_conv_out, D, p.WcT, D, D / 32, false, lds);
  transpose_w(p.w_o, D, p.WoT, D, D / 32, false, lds);
  for (int i = gt; i < INW; i += gn) p.bias_v[i] = p.b_in[vcol(i)];
  for (int i = gt; i < 256 * 16; i += gn) {
    const int pos = i >> 4, f = i & 15;
    const float inv = powf(10000.0f, -(float)(2 * f) / 32.0f);
    const float ang = (float)pos * inv;
    p.tab_cos[i] = cosf(ang); p.tab_sin[i] = sinf(ang);
  }
}

enum { EPI_INPROJ = 0, EPI_CONV = 1, EPI_AOUT = 2, EPI_OUT = 3 };

template <int NCH>
DI void flush_rows(const bf16_t* wlt, bf16_t* dst0, int pitch, int lane) {
  constexpr int RPP = 64 / NCH;
#pragma unroll
  for (int ps = 0; ps < 32 / RPP; ++ps) {
    const int row = ps * RPP + lane / NCH, c = lane % NCH;
    const u32x4 w = *(const u32x4*)(wlt + row * SROWE + c * 8);
    *(u32x4*)(dst0 + (size_t)row * pitch + c * 8) = w;
  }
}

template <int EPI>
__device__ void gemm_tile(const Params& p, const bf16_t* __restrict__ Wt, const bf16_t* __restrict__ X, int tile_n, int tile_m, int row0, int S, bf16_t* lds) {
  constexpr int LDW = EPI == EPI_INPROJ ? PX : D, LDX = EPI == EPI_INPROJ ? PX : D;
  const int tid = TID, lane = tid & 63, wid = tid >> 6, wn = wid >> 1, wm = wid & 1, r = lane & 31, h = lane >> 5;
  const int lrow = tid >> 3, lkc = tid & 7;
  const bf16_t* wsrc = Wt + (size_t)(tile_n * 256 + lrow) * LDW + lkc * 8;
  const bf16_t* xsrc = X + (size_t)(tile_m * 256 + lrow) * LDX + lkc * 8;
  const int gq_ = tile_n * 4 + wn;
  const int st_off = lrow * LROW + lkc * 8;
  f32x16 acc[2][4];
#pragma unroll
  for (int a = 0; a < 2; ++a)
#pragma unroll
    for (int b = 0; b < 4; ++b)
#pragma unroll
      for (int i = 0; i < 16; ++i) acc[a][b][i] = 0.f;
  u32x4 rg[8];
#define G_LOAD(k0) { _Pragma("unroll") for (int i = 0; i < 4; ++i) rg[i] = *(const u32x4*)(wsrc + (size_t)i * 64 * LDW + (k0)); \
                     _Pragma("unroll") for (int i = 0; i < 4; ++i) rg[4 + i] = *(const u32x4*)(xsrc + (size_t)i * 64 * LDX + (k0)); }
#define G_STORE() { _Pragma("unroll") for (int i = 0; i < 4; ++i) *(u32x4*)(lds + st_off + i * 64 * LROW) = rg[i]; \
                    _Pragma("unroll") for (int i = 0; i < 4; ++i) *(u32x4*)(lds + WT + st_off + i * 64 * LROW) = rg[4 + i]; }
  const int wfo = (wn * 64 + swz(r)) * LROW + 8 * h;
  const int xfo = WT + (wm * 128 + r) * LROW + 8 * h;
  constexpr int NK = D / BK;
#pragma unroll 1
  for (int pass = 0; pass < (EPI == EPI_AOUT ? 2 : 1); ++pass) {
  if (EPI == EPI_AOUT && pass == 1) {
    wsrc = p.WcT + (size_t)(tile_n * 256 + lrow) * D + lkc * 8; xsrc = p.conv + (size_t)(tile_m * 256 + lrow) * D + lkc * 8;
#pragma unroll
    for (int mb = 0; mb < 2; ++mb) {
      u32x4 ra[2][2][2], rc[2][2][2];
#pragma unroll
      for (int m2 = 0; m2 < 2; ++m2)
#pragma unroll
        for (int ni = 0; ni < 2; ++ni)
#pragma unroll
          for (int run = 0; run < 2; ++run) {
            const size_t off = (size_t)(tile_m * 256 + wm * 128 + (2 * mb + m2) * 32 + r) * D + 64 * gq_ + 32 * ni + 16 * run + 8 * h;
            ra[m2][ni][run] = *(const u32x4*)(p.sga + off); rc[m2][ni][run] = *(const u32x4*)(p.sgc + off);
          }
      __builtin_amdgcn_sched_barrier(0);
#pragma unroll
      for (int m2 = 0; m2 < 2; ++m2)
#pragma unroll
        for (int ni = 0; ni < 2; ++ni)
#pragma unroll
          for (int run = 0; run < 2; ++run)
#pragma unroll
            for (int j = 0; j < 4; ++j) {
              const unsigned wa = ra[m2][ni][run][j], wc = rc[m2][ni][run][j];
              acc[ni][2 * mb + m2][8 * run + 2 * j] *= bflo(wa) * __builtin_amdgcn_rcpf(fmaxf(bflo(wc), 1e-30f));
              acc[ni][2 * mb + m2][8 * run + 2 * j + 1] *= bfhi(wa) * __builtin_amdgcn_rcpf(fmaxf(bfhi(wc), 1e-30f));
            }
      __builtin_amdgcn_sched_barrier(0);
    }
  }
  G_LOAD(0);
#pragma unroll 1
  for (int kt = 0; kt < NK; ++kt) {
    G_STORE();
    __syncthreads();
    if (kt + 1 < NK) G_LOAD((kt + 1) * BK);
    __builtin_amdgcn_sched_barrier(0);
#pragma unroll
    for (int ks = 0; ks < 4; ++ks) {
      bf16x8 wf[2], xf[4];
#pragma unroll
      for (int ni = 0; ni < 2; ++ni) wf[ni] = *(const bf16x8*)(lds + wfo + ni * 32 * LROW + ks * 16);
#pragma unroll
      for (int mi = 0; mi < 4; ++mi) xf[mi] = *(const bf16x8*)(lds + xfo + mi * 32 * LROW + ks * 16);
      __builtin_amdgcn_s_setprio(1);
#pragma unroll
      for (int ni = 0; ni < 2; ++ni)
#pragma unroll
        for (int mi = 0; mi < 4; ++mi) acc[ni][mi] = __builtin_amdgcn_mfma_f32_32x32x16_bf16(wf[ni], xf[mi], acc[ni][mi], 0, 0, 0);
      __builtin_amdgcn_s_setprio(0);
    }
    __builtin_amdgcn_sched_barrier(0);
    __syncthreads();
  }
  }
#undef G_LOAD
#undef G_STORE

  const int g = tile_n * 4 + wn;
  bf16_t* const wlt = lds + (GBUF > 4 * ATILE ? GBUF : 4 * ATILE) + wid * STG;
  bf16_t* const wl = wlt + r * SROWE;
  if (EPI == EPI_INPROJ) {
    {
      float bz[2][16];
#pragma unroll
      for (int ni = 0; ni < 2; ++ni)
#pragma unroll
        for (int run = 0; run < 2; ++run) load8f(p.bias_v + 64 * g + 32 * ni + 16 * run + 8 * h, &bz[ni][8 * run]);
      __builtin_amdgcn_sched_barrier(0);
#pragma unroll
      for (int mi = 0; mi < 4; ++mi)
#pragma unroll
        for (int ni = 0; ni < 2; ++ni)
#pragma unroll
          for (int i = 0; i < 16; ++i) acc[ni][mi][i] += bz[ni][i];
    }
    if (g < 20) {
      const float* gain = g < 16 ? p.q_gain : p.k_gain;
      const float osc = g < 16 ? QSCALE : 1.0f;
      float gn[2][16];
#pragma unroll
      for (int ni = 0; ni < 2; ++ni) { load8f(gain + 32 * ni + 8 * h, &gn[ni][0]); load8f(gain + 32 * ni + 16 + 8 * h, &gn[ni][8]); }
#pragma unroll
      for (int mi = 0; mi < 4; ++mi) {
        const int tl = tile_m * 256 + wm * 128 + mi * 32 + r, t = tl & (S - 1);
        float cs[2][8], sn[2][8];
#pragma unroll
        for (int ni = 0; ni < 2; ++ni) { const int pos = ni ? (t & 63) : (t >> 6); load8f(p.tab_cos + pos * 16 + 8 * h, cs[ni]); load8f(p.tab_sin + pos * 16 + 8 * h, sn[ni]); }
        float ss = 0.f;
#pragma unroll
        for (int ni = 0; ni < 2; ++ni)
#pragma unroll
          for (int i = 0; i < 16; ++i) ss += acc[ni][mi][i] * acc[ni][mi][i];
        ss += __shfl_xor(ss, 32);
        const float rinv = rsqrtf(ss * (1.0f / 64.0f) + 1e-6f);
        const int tl0 = tile_m * 256 + wm * 128 + mi * 32;
        bf16_t* dst0 = g < 16 ? p.Q + (size_t)tl0 * D + 64 * g : p.Kb + (size_t)tl0 * 256 + 64 * (g - 16);
#pragma unroll
        for (int ni = 0; ni < 2; ++ni) {
          float o1[8], o2[8];
#pragma unroll
          for (int j = 0; j < 8; ++j) {
            const float a = acc[ni][mi][j] * rinv * gn[ni][j], b = acc[ni][mi][8 + j] * rinv * gn[ni][8 + j];
            o1[j] = (a * cs[ni][j] - b * sn[ni][j]) * osc; o2[j] = (b * cs[ni][j] + a * sn[ni][j]) * osc;
          }
          store8(wl + 32 * ni + 8 * h, o1); store8(wl + 32 * ni + 16 + 8 * h, o2);
        }
        flush_rows<8>(wlt, dst0, g < 16 ? D : 256, lane);
      }
    } else {
#pragma unroll
      for (int mi = 0; mi < 4; ++mi) {
        const int tl = tile_m * 256 + wm * 128 + mi * 32 + r;
        if (g < 24) {
          const int kvh = g - 20, sl = tl / S, t = tl & (S - 1);
          bf16_t* dst = p.Vt + (size_t)((sl * 4 + kvh) * 64) * S + t;
#pragma unroll
          for (int ni = 0; ni < 2; ++ni)
#pragma unroll
            for (int i = 0; i < 16; ++i) {
              const int d = 32 * ni + (i & 7) + 8 * h + 16 * (i >> 3);
              dst[(size_t)d * S] = (bf16_t)(pk2(acc[ni][mi][i], 0.f) & 0xffffu);
            }
        } else if (g < 40) {
          bf16_t* dst0 = p.sza + (size_t)(tl - r) * D + 64 * (g - 24);
#pragma unroll
          for (int ni = 0; ni < 2; ++ni)
#pragma unroll
            for (int run = 0; run < 2; ++run) {
              float o[8];
#pragma unroll
              for (int j = 0; j < 8; ++j) o[j] = siluf_(acc[ni][mi][8 * run + j]);
              store8(wl + 32 * ni + 16 * run + 8 * h, o);
            }
          flush_rows<8>(wlt, dst0, D, lane);
        } else if (g < 104) {
          const bool isU = g < 72;
          bf16_t* dst0 = (isU ? p.U + 32 * (g - 40) : p.G + 32 * (g - 72)) + (size_t)(tl - r) * D;
#pragma unroll
          for (int run = 0; run < 2; ++run) {
            float o[8];
#pragma unroll
            for (int j = 0; j < 8; ++j) o[j] = isU ? acc[0][mi][8 * run + j] * acc[1][mi][8 * run + j] : acc[0][mi][8 * run + j] * siluf_(acc[1][mi][8 * run + j]);
            store8(wl + 16 * run + 8 * h, o);
          }
          flush_rows<4>(wlt, dst0, D, lane);
        } else {
          bf16_t* dst0 = (g < 120 ? p.sga + 64 * (g - 104) : p.sgc + 64 * (g - 120)) + (size_t)(tl - r) * D;
#pragma unroll
          for (int ni = 0; ni < 2; ++ni)
#pragma unroll
            for (int run = 0; run < 2; ++run) {
              float o[8];
#pragma unroll
              for (int j = 0; j < 8; ++j) o[j] = sigmoidf_(acc[ni][mi][8 * run + j]);
              store8(wl + 32 * ni + 16 * run + 8 * h, o);
            }
          flush_rows<8>(wlt, dst0, D, lane);
        }
      }
    }
  }
  if (EPI == EPI_AOUT) {
    u32x4 rc[4][2][2];
#pragma unroll
    for (int mi = 0; mi < 4; ++mi)
#pragma unroll
      for (int ni = 0; ni < 2; ++ni)
#pragma unroll
        for (int run = 0; run < 2; ++run)
          rc[mi][ni][run] = *(const u32x4*)(p.sgc + (size_t)(tile_m * 256 + wm * 128 + mi * 32 + r) * D + 64 * g + 32 * ni + 16 * run + 8 * h);
    __builtin_amdgcn_sched_barrier(0);
#pragma unroll
    for (int mi = 0; mi < 4; ++mi)
#pragma unroll
      for (int ni = 0; ni < 2; ++ni)
#pragma unroll
        for (int run = 0; run < 2; ++run) {
          float o[8];
#pragma unroll
          for (int j = 0; j < 4; ++j) { const unsigned wc = rc[mi][ni][run][j]; o[2 * j] = acc[ni][mi][8 * run + 2 * j] * bflo(wc); o[2 * j + 1] = acc[ni][mi][8 * run + 2 * j + 1] * bfhi(wc); }
          store8(p.G + (size_t)(tile_m * 256 + wm * 128 + mi * 32 + r) * D + 64 * g + 32 * ni + 16 * run + 8 * h, o);
        }
  }
  if (EPI == EPI_OUT) {
#pragma unroll
    for (int mb = 0; mb < 2; ++mb) {
      f32x4 xr[2][2][2][2];
#pragma unroll
      for (int m2 = 0; m2 < 2; ++m2)
#pragma unroll
        for (int ni = 0; ni < 2; ++ni)
#pragma unroll
          for (int run = 0; run < 2; ++run) {
            const int tl = tile_m * 256 + wm * 128 + (2 * mb + m2) * 32 + r;
            const float* xp_ = xrow(p, row0 + tl) + 64 * g + 32 * ni + 16 * run + 8 * h;
            xr[m2][ni][run][0] = *(const f32x4*)xp_; xr[m2][ni][run][1] = *(const f32x4*)(xp_ + 4);
          }
      __builtin_amdgcn_sched_barrier(0);
#pragma unroll
      for (int m2 = 0; m2 < 2; ++m2)
#pragma unroll
        for (int ni = 0; ni < 2; ++ni)
#pragma unroll
          for (int run = 0; run < 2; ++run) {
            const int mi = 2 * mb + m2, tl = tile_m * 256 + wm * 128 + mi * 32 + r;
            float* dst = p.out + (size_t)(row0 + tl) * D + 64 * g + 32 * ni + 16 * run + 8 * h;
            f32x4 a, b;
#pragma unroll
            for (int j = 0; j < 4; ++j) { a[j] = DN_ALPHA * xr[m2][ni][run][0][j] + acc[ni][mi][8 * run + j]; b[j] = DN_ALPHA * xr[m2][ni][run][1][j] + acc[ni][mi][8 * run + 4 + j]; }
            *(f32x4*)dst = a; *(f32x4*)(dst + 4) = b;
          }
      __builtin_amdgcn_sched_barrier(0);
    }
  }
}

__device__ void phase_conv(const Params& p, int S, int nrows) {
  const int gt = BID * NTHR + TID, gn = gridDim.x * NTHR;
  for (int i = gt; i < (nrows >> 2) * 128; i += gn) {
    const int tl0 = (i >> 7) * 4, c8 = (i & 127) * 8, t0 = tl0 & (S - 1);
    float u[6][8], gg[4][8], w0[8], w1[8], w2[8], b[8];
    const bf16_t* up_ = p.U + (size_t)tl0 * D + c8;
    if (t0 > 0) load8(up_ - D, u[0]); else {
#pragma unroll
      for (int j = 0; j < 8; ++j) u[0][j] = 0.f; }
#pragma unroll
    for (int k = 0; k < 4; ++k) load8(up_ + (size_t)k * D, u[k + 1]);
    if (t0 + 4 < S) load8(up_ + (size_t)4 * D, u[5]); else {
#pragma unroll
      for (int j = 0; j < 8; ++j) u[5][j] = 0.f; }
#pragma unroll
    for (int k = 0; k < 4; ++k) load8(p.G + (size_t)(tl0 + k) * D + c8, gg[k]);
    load8f(p.conv_w + c8, w0); load8f(p.conv_w + D + c8, w1); load8f(p.conv_w + 2 * D + c8, w2); load8f(p.conv_b + c8, b);
#pragma unroll
    for (int k = 0; k < 4; ++k) {
      float o[8];
#pragma unroll
      for (int j = 0; j < 8; ++j) o[j] = gg[k][j] * (w0[j] * u[k][j] + w1[j] * u[k + 1][j] + w2[j] * u[k + 2][j] + b[j]);
      store8(p.conv + (size_t)(tl0 + k) * D + c8, o);
    }
  }
}

__device__ void attn_unit(const Params& p, int S, int unit, bf16_t* lds) {
  const int tid = TID, lane = tid & 63, wid = tid >> 6, r = lane & 31, h = lane >> 5;
  const int nqb = S >> 9;
  const int qb = unit % nqb, hq4 = (unit / nqb) & 3, kvh = (unit / (4 * nqb)) & 3, sl = unit / (16 * nqb);
  const int head = kvh * 4 + hq4;
  float gq = fabsf(p.q_gain[lane]), gk = fabsf(p.k_gain[lane]);
#pragma unroll
  for (int o = 32; o > 0; o >>= 1) { gq = fmaxf(gq, __shfl_xor(gq, o)); gk = fmaxf(gk, __shfl_xor(gk, o)); }
  const float negM = -(64.0f * gq * gk * QSCALE * 1.02f);
  const int tq = sl * S + qb * 512 + wid * 64 + r;
  bf16x8 qf[2][4];
#pragma unroll
  for (int q2 = 0; q2 < 2; ++q2)
#pragma unroll
    for (int st = 0; st < 4; ++st) qf[q2][st] = *(const bf16x8*)(p.Q + (size_t)(tq + 32 * q2) * D + head * 64 + 16 * st + 8 * h);
  const bf16_t* Kg = p.Kb + (size_t)(sl * S) * 256 + kvh * 64;
  const bf16_t* Vg = p.Vt + (size_t)((sl * 4 + kvh) * 64) * S;
  const int lr = tid >> 3, lc = (tid & 7) * 8;
  const bf16_t* ksrc = Kg + (size_t)lr * 256 + lc;
  const bf16_t* vsrc = Vg + (size_t)lr * S + lc;
  const int st_off = lr * AROW + lc;
  u32x4 ta[2];
#define A_LOAD(R, kk) { const size_t kk_ = (size_t)(kk); R[0] = *(const u32x4*)(ksrc + kk_ * 256); R[1] = *(const u32x4*)(vsrc + kk_); }
#define A_STORE(R, buf) { bf16_t* sb_ = lds + (buf) * 2 * ATILE; *(u32x4*)(sb_ + st_off) = R[0]; *(u32x4*)(sb_ + ATILE + st_off) = R[1]; }
  f32x16 o[2][2];
#pragma unroll
  for (int a = 0; a < 2; ++a)
#pragma unroll
    for (int b = 0; b < 2; ++b)
#pragma unroll
      for (int i = 0; i < 16; ++i) o[a][b][i] = 0.f;
  float ls[2] = {0.f, 0.f};
  const int fo = swz(r) * AROW + 8 * h;
  const int nt = S >> 6;
#define A_COMPUTE(buf) { const bf16_t* kb_ = lds + (buf) * 2 * ATILE; const bf16_t* vb_ = kb_ + ATILE; \
    _Pragma("unroll") for (int kb = 0; kb < 2; ++kb) { \
      __builtin_amdgcn_sched_barrier(0); \
      bf16x8 kf[4], vf[2][2]; \
      _Pragma("unroll") for (int st = 0; st < 4; ++st) kf[st] = *(const bf16x8*)(kb_ + fo + kb * 32 * AROW + 16 * st); \
      _Pragma("unroll") for (int sp = 0; sp < 2; ++sp) _Pragma("unroll") for (int dt = 0; dt < 2; ++dt) vf[sp][dt] = *(const bf16x8*)(vb_ + fo + dt * 32 * AROW + kb * 32 + sp * 16); \
      f32x16 sx[2]; \
      _Pragma("unroll") for (int q2 = 0; q2 < 2; ++q2) _Pragma("unroll") for (int i = 0; i < 16; ++i) sx[q2][i] = negM; \
      __builtin_amdgcn_s_setprio(1); \
      _Pragma("unroll") for (int st = 0; st < 4; ++st) _Pragma("unroll") for (int q2 = 0; q2 < 2; ++q2) sx[q2] = __builtin_amdgcn_mfma_f32_32x32x16_bf16(kf[st], qf[q2][st], sx[q2], 0, 0, 0); \
      __builtin_amdgcn_s_setprio(0); \
      bf16x8 pf[2][2]; \
      _Pragma("unroll") for (int q2 = 0; q2 < 2; ++q2) { \
        _Pragma("unroll") for (int i = 0; i < 16; ++i) { sx[q2][i] = __builtin_amdgcn_exp2f(sx[q2][i]); ls[q2] += sx[q2][i]; } \
        _Pragma("unroll") for (int sp = 0; sp < 2; ++sp) { u32x4 pw; \
          pw.x = pk2(sx[q2][8 * sp + 0], sx[q2][8 * sp + 1]); pw.y = pk2(sx[q2][8 * sp + 2], sx[q2][8 * sp + 3]); \
          pw.z = pk2(sx[q2][8 * sp + 4], sx[q2][8 * sp + 5]); pw.w = pk2(sx[q2][8 * sp + 6], sx[q2][8 * sp + 7]); \
          pf[q2][sp] = __builtin_bit_cast(bf16x8, pw); } } \
      __builtin_amdgcn_s_setprio(1); \
      _Pragma("unroll") for (int sp = 0; sp < 2; ++sp) _Pragma("unroll") for (int dt = 0; dt < 2; ++dt) _Pragma("unroll") for (int q2 = 0; q2 < 2; ++q2) \
        o[q2][dt] = __builtin_amdgcn_mfma_f32_32x32x16_bf16(vf[sp][dt], pf[q2][sp], o[q2][dt], 0, 0, 0); \
      __builtin_amdgcn_s_setprio(0); } }
  A_LOAD(ta, 0);
  A_STORE(ta, 0);
  __syncthreads();
#pragma unroll 1
  for (int it = 0; it < nt; ++it) {
    const bool more = it + 1 < nt;
    if (more) A_LOAD(ta, (it + 1) * 64);
    __builtin_amdgcn_sched_barrier(0);
    const int bsel = it & 1;
    A_COMPUTE(bsel);
    __builtin_amdgcn_sched_barrier(0);
    if (more) A_STORE(ta, bsel ^ 1);
    __syncthreads();
  }
#undef A_LOAD
#undef A_STORE
#undef A_COMPUTE
  u32x4 zr[2][2][2];
#pragma unroll
  for (int q2 = 0; q2 < 2; ++q2)
#pragma unroll
    for (int dt = 0; dt < 2; ++dt)
#pragma unroll
      for (int run = 0; run < 2; ++run) zr[q2][dt][run] = *(const u32x4*)(p.sza + (size_t)(tq + 32 * q2) * D + head * 64 + 32 * dt + 16 * run + 8 * h);
  __builtin_amdgcn_sched_barrier(0);
#pragma unroll
  for (int q2 = 0; q2 < 2; ++q2) {
    float lsum = ls[q2];
    lsum += __shfl_xor(lsum, 32);
    const float inv = __frcp_rn(lsum);
#pragma unroll
    for (int dt = 0; dt < 2; ++dt)
#pragma unroll
      for (int run = 0; run < 2; ++run) {
        const size_t off = (size_t)(tq + 32 * q2) * D + head * 64 + 32 * dt + 16 * run + 8 * h;
        float w[8];
#pragma unroll
        for (int j = 0; j < 4; ++j) { const unsigned z = zr[q2][dt][run][j]; w[2 * j] = o[q2][dt][8 * run + 2 * j] * inv * bflo(z); w[2 * j + 1] = o[q2][dt][8 * run + 2 * j + 1] * inv * bfhi(z); }
        store8(p.Q + off, w);
      }
  }
}

__device__ void phase_ln(const Params& p, int row0, int nrows) {
  const int tid = TID, lane = tid & 63, wid = tid >> 6;
  f32x4 gg[4], bb[4];
#pragma unroll
  for (int i = 0; i < 4; ++i) { gg[i] = *(const f32x4*)(p.ln_g + i * 256 + lane * 4); bb[i] = *(const f32x4*)(p.ln_b + i * 256 + lane * 4); }
  constexpr int LNR = 4;
  for (int rr = (BID * (NTHR / 64) + wid) * LNR; rr < nrows; rr += gridDim.x * (NTHR / 64) * LNR) {
    float* row = p.out + (size_t)(row0 + rr) * D;
    f32x4 v[LNR][4];
    float s[LNR];
#pragma unroll
    for (int u = 0; u < LNR; ++u) s[u] = 0.f;
#pragma unroll
    for (int u = 0; u < LNR; ++u)
#pragma unroll
      for (int i = 0; i < 4; ++i) { v[u][i] = __builtin_nontemporal_load((const f32x4*)(row + u * D + i * 256 + lane * 4)); s[u] += (v[u][i].x + v[u][i].y) + (v[u][i].z + v[u][i].w); }
#pragma unroll
    for (int o = 32; o > 0; o >>= 1) {
#pragma unroll
      for (int u = 0; u < LNR; ++u) s[u] += __shfl_xor(s[u], o); }
#pragma unroll
    for (int u = 0; u < LNR; ++u) {
      const float mu = s[u] * (1.0f / D);
      float q = 0.f;
#pragma unroll
      for (int i = 0; i < 4; ++i) { v[u][i] = v[u][i] - mu; q += (v[u][i].x * v[u][i].x + v[u][i].y * v[u][i].y) + (v[u][i].z * v[u][i].z + v[u][i].w * v[u][i].w); }
#pragma unroll
      for (int o = 32; o > 0; o >>= 1) q += __shfl_xor(q, o);
      const float rstd = rsqrtf(q * (1.0f / D) + 1e-5f);
#pragma unroll
      for (int i = 0; i < 4; ++i) __builtin_nontemporal_store(v[u][i] * rstd * gg[i] + bb[i], (f32x4*)(row + u * D + i * 256 + lane * 4));
    }
  }
}

#define XB_TMO      128
#define XB_XCNT(j)  (256  + 64 * (j))
#define XB_XSUB(j)  (1280 + 64 * (j))
#define XB_XGEN(j)  (2304 + 64 * (j))
#define XB_TOP      3328
#define XB_TOPGEN   3392
#define XCD_BAR_WORDS 3456
#define XB_SPIN_CAP (1u << 22)
DI unsigned xb_ld(unsigned* p) { return __hip_atomic_load(p, __ATOMIC_RELAXED, __HIP_MEMORY_SCOPE_AGENT); }
DI unsigned xb_add(unsigned* p, unsigned v) { return __hip_atomic_fetch_add(p, v, __ATOMIC_RELAXED, __HIP_MEMORY_SCOPE_AGENT); }
DI unsigned xb_xcc_id() { return (unsigned)__builtin_amdgcn_s_getreg((3 << 11) | 20) & 0xFu; }
#define XB_SPIN(cond, bar) do { unsigned _sp = 0; while (cond) { __builtin_amdgcn_s_sleep(1); \
    if ((++_sp & 255u) == 0u) { if (xb_ld(&(bar)[XB_TMO])) break; if (_sp > XB_SPIN_CAP) { atomicAdd(&(bar)[XB_TMO], 1u); break; } } } } while (0)
DI void xcd_barrier_complete(unsigned* bar, unsigned x, unsigned& nloc, unsigned& nx) {
  const unsigned G = gridDim.x;
  unsigned sum, cnt, mine, sp = 0u;
  for (;;) {
    sum = 0u; cnt = 0u; mine = 0u;
#pragma unroll
    for (unsigned j = 0; j < 16; ++j) { const unsigned c = xb_ld(&bar[XB_XCNT(j)]); sum += c; cnt += (c > 0u) ? 1u : 0u; mine = (j == x) ? c : mine; }
    if (sum == G) break;
    __builtin_amdgcn_s_sleep(1);
    if ((++sp & 255u) == 0u) { if (xb_ld(&bar[XB_TMO])) break; if (sp > XB_SPIN_CAP) { atomicAdd(&bar[XB_TMO], 1u); break; } }
  }
  nloc = mine > 0u ? mine : 1u; nx = cnt > 0u ? cnt : 1u;
}
#define LAS __attribute__((address_space(3)))
DI void xcd_barrier(unsigned* bar, unsigned x, volatile LAS unsigned* st) {
  asm volatile("s_waitcnt vmcnt(0)" ::: "memory");
  __syncthreads();
  if (threadIdx.x == 0) {
    __builtin_amdgcn_s_waitcnt(0);
    unsigned nloc = st[0], nx = st[1];
    if (nloc == 0u) { xcd_barrier_complete(bar, x, nloc, nx); st[0] = nloc; st[1] = nx; }
    const unsigned old = xb_add(&bar[XB_XSUB(x)], 1u);
    const unsigned gen = old / nloc;
    if (old + 1u == (gen + 1u) * nloc) {
      __builtin_amdgcn_fence(__ATOMIC_RELEASE, "agent");
      asm volatile("s_waitcnt vmcnt(0)" ::: "memory");
      const unsigned og = xb_add(&bar[XB_TOP], 1u);
      const unsigned tg = og / nx;
      if (og + 1u == (tg + 1u) * nx) xb_add(&bar[XB_TOPGEN], 1u);
      else XB_SPIN(xb_ld(&bar[XB_TOPGEN]) == tg, bar);
      __builtin_amdgcn_fence(__ATOMIC_ACQUIRE, "agent");
      xb_add(&bar[XB_XGEN(x)], 1u);
      asm volatile("s_waitcnt vmcnt(0)" ::: "memory");
    } else {
      XB_SPIN(xb_ld(&bar[XB_XGEN(x)]) == gen, bar);
      __builtin_amdgcn_fence(__ATOMIC_ACQUIRE, "agent");
      asm volatile("s_waitcnt vmcnt(0)" ::: "memory");
    }
  }
  __syncthreads();
}

__device__ void run_phase(const Params& p, int ph, bf16_t* lds) {
  if (ph == 0) { phase_prep(p, lds); return; }
  if (ph == NPHASE - 1) { phase_ln(p, 16384, 32768); return; }
  const int c = (ph - 1) / 4, sub = (ph - 1) % 4, row0 = c ? 16384 : 0, nrows = c ? 32768 : 16384, S = c ? 4096 : 16384;
  const int lgmx = c ? 4 : 3, MX = 1 << lgmx, MT = 8 * MX;
  if (sub == 0) {
    const bf16_t* X = p.xb + (size_t)row0 * PX;
    for (int id = BID; id < 34 * MT; id += gridDim.x) {
      const int xcd = id & 7, j = id >> 3, n = j >> lgmx, m = MX * xcd + (j & (MX - 1));
      gemm_tile<EPI_INPROJ>(p, p.WinT, X, n, m, row0, S, lds);
    }
    if (c > 0) phase_ln(p, 0, 16384);
    else convert_x_queue(p, lds);
  } else if (sub == 1) {
    const int nunits = nrows >> 5, UX = nunits >> 3;
    const bool conv_first = ((BID >> 3) & 1) != 0;
    if (conv_first) phase_conv(p, S, nrows);
    for (int id = BID; id < nunits; id += gridDim.x) attn_unit(p, S, UX * (id & 7) + (id >> 3), lds);
    if (!conv_first) phase_conv(p, S, nrows);
  } else if (sub == 2) {
    for (int id = BID; id < 4 * MT; id += gridDim.x) { const int j = id >> 3; gemm_tile<EPI_AOUT>(p, p.WaT, p.Q, j & 3, MX * (id & 7) + (j >> 2), row0, S, lds); }
  } else {
    for (int id = BID; id < 4 * MT; id += gridDim.x) { const int j = id >> 3; gemm_tile<EPI_OUT>(p, p.WoT, p.G, j & 3, MX * (id & 7) + (j >> 2), row0, S, lds); }
  }
}

__global__ void __launch_bounds__(NTHR, 2) mega(Params p, int ph_begin, int ph_end) {
  __shared__ __attribute__((aligned(16))) bf16_t lds[LDS_ELEMS];
  __shared__ uint4 xb_words;
  if (threadIdx.x == 0) xb_words = make_uint4(0u, 0u, 0u, 0u);
  __syncthreads();
  const unsigned xcc = xb_xcc_id();
  if (threadIdx.x == 0 && ph_end - ph_begin > 1) (void)xb_add(&p.bar[XB_XCNT(xcc)], 1u);
  if (ph_begin < 0) cg::this_grid().sync();
  for (int ph = ph_begin; ph < ph_end; ++ph) {
    run_phase(p, ph, lds);
    if (ph + 1 < ph_end) xcd_barrier(p.bar, xcc, (volatile LAS unsigned*)&xb_words);
  }
}

extern "C" void kernel_launch(void* const* d_in, const int* in_sizes, int n_in, void* d_out, int out_size, void* d_ws, size_t ws_size, hipStream_t stream) {
  static int grid_blocks = 0;
  if (!grid_blocks) {
    int dev = 0, cus = 0, per_cu = 0;
    hipGetDevice(&dev);
    hipDeviceGetAttribute(&cus, hipDeviceAttributeMultiprocessorCount, dev);
    hipOccupancyMaxActiveBlocksPerMultiprocessor(&per_cu, mega, NTHR, 0);
    if (per_cu > 1) per_cu = 1;
    if (per_cu < 1) per_cu = 1;
    if (per_cu > 4) per_cu = 4;
    grid_blocks = cus * per_cu;
  }
  Params p{};
  p.xp = (const float*)d_in[0]; p.xs = (const float*)d_in[1]; p.w_in = (const float*)d_in[2]; p.b_in = (const float*)d_in[3];
  p.q_gain = (const float*)d_in[4]; p.k_gain = (const float*)d_in[5]; p.conv_w = (const float*)d_in[6]; p.conv_b = (const float*)d_in[7];
  p.w_attn_out = (const float*)d_in[8]; p.w_conv_out = (const float*)d_in[9]; p.w_o = (const float*)d_in[10];
  p.ln_g = (const float*)d_in[11]; p.ln_b = (const float*)d_in[12];
  p.out = (float*)d_out;
  char* w = (char*)d_ws; size_t off = 0;
  auto take = [&](size_t bytes) { char* q = w + off; off += (bytes + 255) & ~(size_t)255; return q; };
  p.WinT = (bf16_t*)take((size_t)INW * PX * 2);
  p.WaT = (bf16_t*)take((size_t)D * D * 2); p.WcT = (bf16_t*)take((size_t)D * D * 2); p.WoT = (bf16_t*)take((size_t)D * D * 2);
  p.bias_v = (float*)take(INW * 4); p.tab_cos = (float*)take(256 * 16 * 4); p.tab_sin = (float*)take(256 * 16 * 4);
  p.xb = (bf16_t*)take((size_t)T_ALL * PX * 2);
  p.Q = (bf16_t*)take((size_t)CHMAX * D * 2); p.Kb = (bf16_t*)take((size_t)CHMAX * 256 * 2); p.Vt = (bf16_t*)take((size_t)CHMAX * 256 * 2);
  p.sza = (bf16_t*)take((size_t)CHMAX * D * 2); p.U = (bf16_t*)take((size_t)CHMAX * D * 2); p.G = (bf16_t*)take((size_t)CHMAX * D * 2);
  p.sga = (bf16_t*)take((size_t)CHMAX * D * 2); p.sgc = (bf16_t*)take((size_t)CHMAX * D * 2); p.conv = (bf16_t*)take((size_t)CHMAX * D * 2);
  p.mc = p.sgc;
  p.bar = (unsigned*)take(XCD_BAR_WORDS * 4);
  if (off > ws_size) { fprintf(stderr, "workspace too small: need %zu have %zu\n", off, ws_size); return; }
#if MK_SINGLE
  hipMemsetAsync(p.bar, 0, XCD_BAR_WORDS * 4, stream);
  int b = 0, e = NPHASE;
  void* args[] = {&p, &b, &e};
  hipError_t err = hipLaunchCooperativeKernel((void*)mega, dim3(grid_blocks), dim3(NTHR), args, 0, stream);
  if (err != hipSuccess) fprintf(stderr, "cooperative launch failed: %s (grid %d)\n", hipGetErrorString(err), grid_blocks);
#else
  for (int ph = 0; ph < NPHASE; ++ph) hipLaunchKernelGGL(mega, dim3(grid_blocks), dim3(NTHR), 0, stream, p, ph, ph + 1);
#endif
}
```

```cpp
#include <hip/hip_runtime.h>
#include <hip/hip_cooperative_groups.h>
#include <cstdio>
#include <cstdint>
namespace cg = cooperative_groups;

#ifndef ATT_C
#define ATT_C 1.0f
#endif
#ifndef OSC
#define OSC 1.0f
#endif
#ifndef MK_SINGLE
#define MK_SINGLE 1
#endif

typedef unsigned short bf16_t;
typedef short bf16x8 __attribute__((ext_vector_type(8)));
typedef float f32x16 __attribute__((ext_vector_type(16)));
typedef float f32x4 __attribute__((ext_vector_type(4)));
typedef float f32x2 __attribute__((ext_vector_type(2)));
typedef unsigned u32x4 __attribute__((ext_vector_type(4)));
typedef __bf16 bf16x2_t __attribute__((ext_vector_type(2)));
#define DI __device__ __forceinline__
DI int opq_v(int t) { asm volatile("" : "+v"(t)); return t; }
DI int opq_s(int t) { asm volatile("" : "+s"(t)); return t; }
#define TID (opq_v((int)threadIdx.x))
#define BID (opq_s((int)blockIdx.x))

constexpr int D = 1024, INW = 8704, T_ALL = 49152, CHMAX = 32768;
constexpr int BK = 64, LROW = BK + 8, WT = 256 * LROW, XT = 256 * LROW, GBUF = WT + XT;
constexpr int AROW = 72, ATILE = 64 * AROW;
constexpr int SROWE = 72, STG = 32 * SROWE;
constexpr int LDS_ELEMS = (GBUF > 4 * ATILE ? GBUF : 4 * ATILE) + 8 * STG;
constexpr float QSCALE = 0.125f * 1.4426950408889634f;
constexpr float DN_ALPHA = 1.189207115002721f;
constexpr int NPHASE = 10;
constexpr int NTHR = 512;
constexpr int PX = 1088;

struct Params {
  const float* xp; const float* xs; const float* w_in; const float* b_in; const float* q_gain; const float* k_gain;
  const float* conv_w; const float* conv_b; const float* w_attn_out; const float* w_conv_out; const float* w_o;
  const float* ln_g; const float* ln_b;
  float* out;
  bf16_t* WinT; bf16_t* WaT; bf16_t* WcT; bf16_t* WoT; float* bias_v; float* tab_cos; float* tab_sin;
  bf16_t* xb; bf16_t* Q; bf16_t* Kb; bf16_t* Vt; bf16_t* sza; bf16_t* U; bf16_t* G; bf16_t* sga; bf16_t* sgc; bf16_t* conv; bf16_t* mc;
  unsigned* bar;
};

DI unsigned pk2(float lo, float hi) { f32x2 v = {lo, hi}; return __builtin_bit_cast(unsigned, __builtin_convertvector(v, bf16x2_t)); }
DI float bf2f(unsigned short x) { return __uint_as_float(((unsigned)x) << 16); }
DI float bflo(unsigned w) { return __uint_as_float(w << 16); }
DI float bfhi(unsigned w) { return __uint_as_float(w & 0xffff0000u); }
DI int swz(int r) { return (r & ~12) | ((r & 4) << 1) | ((r & 8) >> 1); }
DI float sigmoidf_(float z) { return __builtin_amdgcn_rcpf(1.0f + __builtin_amdgcn_exp2f(-1.4426950408889634f * z)); }
DI float siluf_(float z) { return z * sigmoidf_(z); }
DI void store8(bf16_t* dst, const float* v) {
  u32x4 w; w.x = pk2(v[0], v[1]); w.y = pk2(v[2], v[3]); w.z = pk2(v[4], v[5]); w.w = pk2(v[6], v[7]);
  *(u32x4*)dst = w;
}
DI void load8(const bf16_t* src, float* v) {
  u32x4 w = *(const u32x4*)src;
  v[0] = bflo(w.x); v[1] = bfhi(w.x); v[2] = bflo(w.y); v[3] = bfhi(w.y); v[4] = bflo(w.z); v[5] = bfhi(w.z); v[6] = bflo(w.w); v[7] = bfhi(w.w);
}
DI void load8f_nt(const float* src, float* v) {
  f32x4 a = __builtin_nontemporal_load((const f32x4*)src), b = __builtin_nontemporal_load((const f32x4*)(src + 4));
  v[0] = a.x; v[1] = a.y; v[2] = a.z; v[3] = a.w; v[4] = b.x; v[5] = b.y; v[6] = b.z; v[7] = b.w;
}
DI void load8f(const float* src, float* v) {
  f32x4 a = *(const f32x4*)src, b = *(const f32x4*)(src + 4);
  v[0] = a.x; v[1] = a.y; v[2] = a.z; v[3] = a.w; v[4] = b.x; v[5] = b.y; v[6] = b.z; v[7] = b.w;
}
DI int vcol(int v) {
  const int g = v >> 6, ni = (v >> 5) & 1, f = v & 31;
  if (g >= 40 && g < 72) { const int cb = g - 40; return (ni ? 4608 : 3584) + 32 * cb + f; }
  if (g >= 72 && g < 104) { const int cb = g - 72; return (ni ? 5632 : 2560) + 32 * cb + f; }
  return v;
}
DI const float* xrow(const Params& p, int R) { return R < 16384 ? p.xp + (size_t)R * D : p.xs + (size_t)(R - 16384) * D; }

__device__ void convert_x(const Params& p, int r0, int r1, int bidx, int nblk) {
  const int gt = bidx * NTHR + TID, gn = nblk * NTHR, i0 = r0 * (D / 8), i1 = r1 * (D / 8);
  for (int i = i0 + gt; i < i1; i += 4 * gn) {
    float v[4][8];
#pragma unroll
    for (int u = 0; u < 4; ++u) { const int ii = i + u * gn; if (ii < i1) load8f_nt(xrow(p, ii >> 7) + (ii & 127) * 8, v[u]); }
#pragma unroll
    for (int u = 0; u < 4; ++u) { const int ii = i + u * gn; if (ii < i1) store8(p.xb + (size_t)(ii >> 7) * PX + (ii & 127) * 8, v[u]); }
  }
}

__device__ void transpose_w(const float* __restrict__ src, int ldsrc, bf16_t* __restrict__ dst, int lddst, int ng32, bool virt, bf16_t* lds) {
  const int tid = TID;
  constexpr int TP = 136;
  for (int tile = BID; tile < ng32 * 8; tile += gridDim.x) {
    const int cgp = tile % ng32, kb = tile / ng32, v0 = cgp * 32, col0 = virt ? vcol(v0) : v0, k0 = kb * 128;
    f32x4 x[2];
#pragma unroll
    for (int ps = 0; ps < 2; ++ps) x[ps] = __builtin_nontemporal_load((const f32x4*)(src + (size_t)(k0 + ps * 64 + (tid >> 3)) * ldsrc + col0 + (tid & 7) * 4));
#pragma unroll
    for (int ps = 0; ps < 2; ++ps)
#pragma unroll
      for (int j = 0; j < 4; ++j) lds[((tid & 7) * 4 + j) * TP + ps * 64 + (tid >> 3)] = (bf16_t)(pk2(x[ps][j], 0.f) & 0xffffu);
    __syncthreads();
    const u32x4 w = *(const u32x4*)(lds + (tid >> 4) * TP + (tid & 15) * 8);
    *(u32x4*)(dst + (size_t)(v0 + (tid >> 4)) * lddst + k0 + (tid & 15) * 8) = w;
    __syncthreads();
  }
}

__device__ void phase_prep(const Params& p, bf16_t* lds) {
  const int gt = BID * NTHR + TID, gn = gridDim.x * NTHR;
  convert_x(p, 0, 16384, BID, gridDim.x);
  transpose_w(p.w_in, INW, p.WinT, PX, INW / 32, true, lds);
  transpose_w(p.w_attn_out, D, p.WaT, D, D / 32, false, lds);
  transpose_w(p.w_conv_out, D, p.WcT, D, D / 32, false, lds);
  transpose_w(p.w_o, D, p.WoT, D, D / 32, false, lds);
  for (int i = gt; i < INW; i += gn) p.bias_v[i] = p.b_in[vcol(i)];
  for (int i = gt; i < 256 * 16; i += gn) {
    const int pos = i >> 4, f = i & 15;
    const float inv = powf(10000.0f, -(float)(2 * f) / 32.0f);
    const float ang = (float)pos * inv;
    p.tab_cos[i] = cosf(ang); p.tab_sin[i] = sinf(ang);
  }
}

enum { EPI_INPROJ = 0, EPI_CONV = 1, EPI_AOUT = 2, EPI_OUT = 3 };

template <int NCH>
DI void flush_rows(const bf16_t* wlt, bf16_t* dst0, int pitch, int lane) {
  constexpr int RPP = 64 / NCH;
#pragma unroll
  for (int ps = 0; ps < 32 / RPP; ++ps) {
    const int row = ps * RPP + lane / NCH, c = lane % NCH;
    const u32x4 w = *(const u32x4*)(wlt + row * SROWE + c * 8);
    *(u32x4*)(dst0 + (size_t)row * pitch + c * 8) = w;
  }
}

template <int EPI>
__device__ void gemm_tile(const Params& p, const bf16_t* __restrict__ Wt, const bf16_t* __restrict__ X, int tile_n, int tile_m, int row0, int S, bf16_t* lds) {
  constexpr int LDW = EPI == EPI_INPROJ ? PX : D, LDX = EPI == EPI_INPROJ ? PX : D;
  const int tid = TID, lane = tid & 63, wid = tid >> 6, wn = wid >> 1, wm = wid & 1, r = lane & 31, h = lane >> 5;
  const int lrow = tid >> 3, lkc = tid & 7;
  const bf16_t* wsrc = Wt + (size_t)(tile_n * 256 + lrow) * LDW + lkc * 8;
  const bf16_t* xsrc = X + (size_t)(tile_m * 256 + lrow) * LDX + lkc * 8;
  const int gq_ = tile_n * 4 + wn;
  const int st_off = lrow * LROW + lkc * 8;
  f32x16 acc[2][4];
#pragma unroll
  for (int a = 0; a < 2; ++a)
#pragma unroll
    for (int b = 0; b < 4; ++b)
#pragma unroll
      for (int i = 0; i < 16; ++i) acc[a][b][i] = 0.f;
  u32x4 rg[8];
#define G_LOAD(k0) { _Pragma("unroll") for (int i = 0; i < 4; ++i) rg[i] = *(const u32x4*)(wsrc + (size_t)i * 64 * LDW + (k0)); \
                     _Pragma("unroll") for (int i = 0; i < 4; ++i) rg[4 + i] = *(const u32x4*)(xsrc + (size_t)i * 64 * LDX + (k0)); }
#define G_STORE() { _Pragma("unroll") for (int i = 0; i < 4; ++i) *(u32x4*)(lds + st_off + i * 64 * LROW) = rg[i]; \
                    _Pragma("unroll") for (int i = 0; i < 4; ++i) *(u32x4*)(lds + WT + st_off + i * 64 * LROW) = rg[4 + i]; }
  const int wfo = (wn * 64 + swz(r)) * LROW + 8 * h;
  const int xfo = WT + (wm * 128 + r) * LROW + 8 * h;
  constexpr int NK = D / BK;
#pragma unroll 1
  for (int pass = 0; pass < (EPI == EPI_AOUT ? 2 : 1); ++pass) {
  if (EPI == EPI_AOUT && pass == 1) {
    wsrc = p.WcT + (size_t)(tile_n * 256 + lrow) * D + lkc * 8; xsrc = p.conv + (size_t)(tile_m * 256 + lrow) * D + lkc * 8;
#pragma unroll
    for (int mb = 0; mb < 2; ++mb) {
      u32x4 ra[2][2][2], rc[2][2][2];
#pragma unroll
      for (int m2 = 0; m2 < 2; ++m2)
#pragma unroll
        for (int ni = 0; ni < 2; ++ni)
#pragma unroll
          for (int run = 0; run < 2; ++run) {
            const size_t off = (size_t)(tile_m * 256 + wm * 128 + (2 * mb + m2) * 32 + r) * D + 64 * gq_ + 32 * ni + 16 * run + 8 * h;
            ra[m2][ni][run] = *(const u32x4*)(p.sga + off); rc[m2][ni][run] = *(const u32x4*)(p.sgc + off);
          }
      __builtin_amdgcn_sched_barrier(0);
#pragma unroll
      for (int m2 = 0; m2 < 2; ++m2)
#pragma unroll
        for (int ni = 0; ni < 2; ++ni)
#pragma unroll
          for (int run = 0; run < 2; ++run)
#pragma unroll
            for (int j = 0; j < 4; ++j) {
              const unsigned wa = ra[m2][ni][run][j], wc = rc[m2][ni][run][j];
              acc[ni][2 * mb + m2][8 * run + 2 * j] *= bflo(wa) * __builtin_amdgcn_rcpf(fmaxf(bflo(wc), 1e-30f));
              acc[ni][2 * mb + m2][8 * run + 2 * j + 1] *= bfhi(wa) * __builtin_amdgcn_rcpf(fmaxf(bfhi(wc), 1e-30f));
            }
      __builtin_amdgcn_sched_barrier(0);
    }
  }
  G_LOAD(0);
#pragma unroll 1
  for (int kt = 0; kt < NK; ++kt) {
    G_STORE();
    __syncthreads();
    if (kt + 1 < NK) G_LOAD((kt + 1) * BK);
    __builtin_amdgcn_sched_barrier(0);
#pragma unroll
    for (int ks = 0; ks < 4; ++ks) {
      bf16x8 wf[2], xf[4];
#pragma unroll
      for (int ni = 0; ni < 2; ++ni) wf[ni] = *(const bf16x8*)(lds + wfo + ni * 32 * LROW + ks * 16);
#pragma unroll
      for (int mi = 0; mi < 4; ++mi) xf[mi] = *(const bf16x8*)(lds + xfo + mi * 32 * LROW + ks * 16);
      __builtin_amdgcn_s_setprio(1);
#pragma unroll
      for (int ni = 0; ni < 2; ++ni)
#pragma unroll
        for (int mi = 0; mi < 4; ++mi) acc[ni][mi] = __builtin_amdgcn_mfma_f32_32x32x16_bf16(wf[ni], xf[mi], acc[ni][mi], 0, 0, 0);
      __builtin_amdgcn_s_setprio(0);
    }
    __builtin_amdgcn_sched_barrier(0);
    __syncthreads();
  }
  }
#undef G_LOAD
#undef G_STORE

  const int g = tile_n * 4 + wn;
  bf16_t* const wlt = lds + (GBUF > 4 * ATILE ? GBUF : 4 * ATILE) + wid * STG;
  bf16_t* const wl = wlt + r * SROWE;
  if (EPI == EPI_INPROJ) {
    {
      float bz[2][16];
#pragma unroll
      for (int ni = 0; ni < 2; ++ni)
#pragma unroll
        for (int run = 0; run < 2; ++run) load8f(p.bias_v + 64 * g + 32 * ni + 16 * run + 8 * h, &bz[ni][8 * run]);
      __builtin_amdgcn_sched_barrier(0);
#pragma unroll
      for (int mi = 0; mi < 4; ++mi)
#pragma unroll
        for (int ni = 0; ni < 2; ++ni)
#pragma unroll
          for (int i = 0; i < 16; ++i) acc[ni][mi][i] += bz[ni][i];
    }
    if (g < 20) {
      const float* gain = g < 16 ? p.q_gain : p.k_gain;
      const float osc = g < 16 ? QSCALE : 1.0f;
      float gn[2][16];
#pragma unroll
      for (int ni = 0; ni < 2; ++ni) { load8f(gain + 32 * ni + 8 * h, &gn[ni][0]); load8f(gain + 32 * ni + 16 + 8 * h, &gn[ni][8]); }
#pragma unroll
      for (int mi = 0; mi < 4; ++mi) {
        const int tl = tile_m * 256 + wm * 128 + mi * 32 + r, t = tl & (S - 1);
        float cs[2][8], sn[2][8];
#pragma unroll
        for (int ni = 0; ni < 2; ++ni) { const int pos = ni ? (t & 63) : (t >> 6); load8f(p.tab_cos + pos * 16 + 8 * h, cs[ni]); load8f(p.tab_sin + pos * 16 + 8 * h, sn[ni]); }
        float ss = 0.f;
#pragma unroll
        for (int ni = 0; ni < 2; ++ni)
#pragma unroll
          for (int i = 0; i < 16; ++i) ss += acc[ni][mi][i] * acc[ni][mi][i];
        ss += __shfl_xor(ss, 32);
        const float rinv = rsqrtf(ss * (1.0f / 64.0f) + 1e-6f);
        const int tl0 = tile_m * 256 + wm * 128 + mi * 32;
        bf16_t* dst0 = g < 16 ? p.Q + (size_t)tl0 * D + 64 * g : p.Kb + (size_t)tl0 * 256 + 64 * (g - 16);
#pragma unroll
        for (int ni = 0; ni < 2; ++ni) {
          float o1[8], o2[8];
#pragma unroll
          for (int j = 0; j < 8; ++j) {
            const float a = acc[ni][mi][j] * rinv * gn[ni][j], b = acc[ni][mi][8 + j] * rinv * gn[ni][8 + j];
            o1[j] = (a * cs[ni][j] - b * sn[ni][j]) * osc; o2[j] = (b * cs[ni][j] + a * sn[ni][j]) * osc;
          }
          store8(wl + 32 * ni + 8 * h, o1); store8(wl + 32 * ni + 16 + 8 * h, o2);
        }
        flush_rows<8>(wlt, dst0, g < 16 ? D : 256, lane);
      }
    } else {
#pragma unroll
      for (int mi = 0; mi < 4; ++mi) {
        const int tl = tile_m * 256 + wm * 128 + mi * 32 + r;
        if (g < 24) {
          const int kvh = g - 20, sl = tl / S, t = tl & (S - 1);
          bf16_t* dst = p.Vt + (size_t)((sl * 4 + kvh) * 64) * S + t;
#pragma unroll
          for (int ni = 0; ni < 2; ++ni)
#pragma unroll
            for (int i = 0; i < 16; ++i) {
              const int d = 32 * ni + (i & 7) + 8 * h + 16 * (i >> 3);
              dst[(size_t)d * S] = (bf16_t)(pk2(acc[ni][mi][i], 0.f) & 0xffffu);
            }
        } else if (g < 40) {
          bf16_t* dst0 = p.sza + (size_t)(tl - r) * D + 64 * (g - 24);
#pragma unroll
          for (int ni = 0; ni < 2; ++ni)
#pragma unroll
            for (int run = 0; run < 2; ++run) {
              float o[8];
#pragma unroll
              for (int j = 0; j < 8; ++j) o[j] = siluf_(acc[ni][mi][8 * run + j]);
              store8(wl + 32 * ni + 16 * run + 8 * h, o);
            }
          flush_rows<8>(wlt, dst0, D, lane);
        } else if (g < 104) {
          const bool isU = g < 72;
          bf16_t* dst0 = (isU ? p.U + 32 * (g - 40) : p.G + 32 * (g - 72)) + (size_t)(tl - r) * D;
#pragma unroll
          for (int run = 0; run < 2; ++run) {
            float o[8];
#pragma unroll
            for (int j = 0; j < 8; ++j) o[j] = isU ? acc[0][mi][8 * run + j] * acc[1][mi][8 * run + j] : acc[0][mi][8 * run + j] * siluf_(acc[1][mi][8 * run + j]);
            store8(wl + 16 * run + 8 * h, o);
          }
          flush_rows<4>(wlt, dst0, D, lane);
        } else {
          bf16_t* dst0 = (g < 120 ? p.sga + 64 * (g - 104) : p.sgc + 64 * (g - 120)) + (size_t)(tl - r) * D;
#pragma unroll
          for (int ni = 0; ni < 2; ++ni)
#pragma unroll
            for (int run = 0; run < 2; ++run) {
              float o[8];
#pragma unroll
              for (int j = 0; j < 8; ++j) o[j] = sigmoidf_(acc[ni][mi][8 * run + j]);
              store8(wl + 32 * ni + 16 * run + 8 * h, o);
            }
          flush_rows<8>(wlt, dst0, D, lane);
        }
      }
    }
  }
  if (EPI == EPI_AOUT) {
    u32x4 rc[4][2][2];
#pragma unroll
    for (int mi = 0; mi < 4; ++mi)
#pragma unroll
      for (int ni = 0; ni < 2; ++ni)
#pragma unroll
        for (int run = 0; run < 2; ++run)
          rc[mi][ni][run] = *(const u32x4*)(p.sgc + (size_t)(tile_m * 256 + wm * 128 + mi * 32 + r) * D + 64 * g + 32 * ni + 16 * run + 8 * h);
    __builtin_amdgcn_sched_barrier(0);
#pragma unroll
    for (int mi = 0; mi < 4; ++mi)
#pragma unroll
      for (int ni = 0; ni < 2; ++ni)
#pragma unroll
        for (int run = 0; run < 2; ++run) {
          float o[8];
#pragma unroll
          for (int j = 0; j < 4; ++j) { const unsigned wc = rc[mi][ni][run][j]; o[2 * j] = acc[ni][mi][8 * run + 2 * j] * bflo(wc); o[2 * j + 1] = acc[ni][mi][8 * run + 2 * j + 1] * bfhi(wc); }
          store8(p.G + (size_t)(tile_m * 256 + wm * 128 + mi * 32 + r) * D + 64 * g + 32 * ni + 16 * run + 8 * h, o);
        }
  }
  if (EPI == EPI_OUT) {
#pragma unroll
    for (int mb = 0; mb < 2; ++mb) {
      f32x4 xr[2][2][2][2];
#pragma unroll
      for (int m2 = 0; m2 < 2; ++m2)
#pragma unroll
        for (int ni = 0; ni < 2; ++ni)
#pragma unroll
          for (int run = 0; run < 2; ++run) {
            const int tl = tile_m * 256 + wm * 128 + (2 * mb + m2) * 32 + r;
            const float* xp_ = xrow(p, row0 + tl) + 64 * g + 32 * ni + 16 * run + 8 * h;
            xr[m2][ni][run][0] = *(const f32x4*)xp_; xr[m2][ni][run][1] = *(const f32x4*)(xp_ + 4);
          }
      __builtin_amdgcn_sched_barrier(0);
#pragma unroll
      for (int m2 = 0; m2 < 2; ++m2)
#pragma unroll
        for (int ni = 0; ni < 2; ++ni)
#pragma unroll
          for (int run = 0; run < 2; ++run) {
            const int mi = 2 * mb + m2, tl = tile_m * 256 + wm * 128 + mi * 32 + r;
            float* dst = p.out + (size_t)(row0 + tl) * D + 64 * g + 32 * ni + 16 * run + 8 * h;
            f32x4 a, b;
#pragma unroll
            for (int j = 0; j < 4; ++j) { a[j] = DN_ALPHA * xr[m2][ni][run][0][j] + acc[ni][mi][8 * run + j]; b[j] = DN_ALPHA * xr[m2][ni][run][1][j] + acc[ni][mi][8 * run + 4 + j]; }
            *(f32x4*)dst = a; *(f32x4*)(dst + 4) = b;
          }
      __builtin_amdgcn_sched_barrier(0);
    }
  }
}

__device__ void phase_conv(const Params& p, int S, int nrows) {
  const int gt = BID * NTHR + TID, gn = gridDim.x * NTHR;
  for (int i = gt; i < (nrows >> 2) * 128; i += gn) {
    const int tl0 = (i >> 7) * 4, c8 = (i & 127) * 8, t0 = tl0 & (S - 1);
    float u[6][8], gg[4][8], w0[8], w1[8], w2[8], b[8];
    const bf16_t* up_ = p.U + (size_t)tl0 * D + c8;
    if (t0 > 0) load8(up_ - D, u[0]); else {
#pragma unroll
      for (int j = 0; j < 8; ++j) u[0][j] = 0.f; }
#pragma unroll
    for (int k = 0; k < 4; ++k) load8(up_ + (size_t)k * D, u[k + 1]);
    if (t0 + 4 < S) load8(up_ + (size_t)4 * D, u[5]); else {
#pragma unroll
      for (int j = 0; j < 8; ++j) u[5][j] = 0.f; }
#pragma unroll
    for (int k = 0; k < 4; ++k) load8(p.G + (size_t)(tl0 + k) * D + c8, gg[k]);
    load8f(p.conv_w + c8, w0); load8f(p.conv_w + D + c8, w1); load8f(p.conv_w + 2 * D + c8, w2); load8f(p.conv_b + c8, b);
#pragma unroll
    for (int k = 0; k < 4; ++k) {
      float o[8];
#pragma unroll
      for (int j = 0; j < 8; ++j) o[j] = gg[k][j] * (w0[j] * u[k][j] + w1[j] * u[k + 1][j] + w2[j] * u[k + 2][j] + b[j]);
      store8(p.conv + (size_t)(tl0 + k) * D + c8, o);
    }
  }
}

__device__ void attn_unit(const Params& p, int S, int unit, bf16_t* lds) {
  const int tid = TID, lane = tid & 63, wid = tid >> 6, r = lane & 31, h = lane >> 5;
  const int nqb = S >> 9;
  const int qb = unit % nqb, hq4 = (unit / nqb) & 3, kvh = (unit / (4 * nqb)) & 3, sl = unit / (16 * nqb);
  const int head = kvh * 4 + hq4;
  float gq = fabsf(p.q_gain[lane]), gk = fabsf(p.k_gain[lane]);
#pragma unroll
  for (int o = 32; o > 0; o >>= 1) { gq = fmaxf(gq, __shfl_xor(gq, o)); gk = fmaxf(gk, __shfl_xor(gk, o)); }
  const float negM = -(64.0f * gq * gk * QSCALE * 1.02f);
  const int tq = sl * S + qb * 512 + wid * 64 + r;
  bf16x8 qf[2][4];
#pragma unroll
  for (int q2 = 0; q2 < 2; ++q2)
#pragma unroll
    for (int st = 0; st < 4; ++st) qf[q2][st] = *(const bf16x8*)(p.Q + (size_t)(tq + 32 * q2) * D + head * 64 + 16 * st + 8 * h);
  const bf16_t* Kg = p.Kb + (size_t)(sl * S) * 256 + kvh * 64;
  const bf16_t* Vg = p.Vt + (size_t)((sl * 4 + kvh) * 64) * S;
  const int lr = tid >> 3, lc = (tid & 7) * 8;
  const bf16_t* ksrc = Kg + (size_t)lr * 256 + lc;
  const bf16_t* vsrc = Vg + (size_t)lr * S + lc;
  const int st_off = lr * AROW + lc;
  u32x4 ta[2];
#define A_LOAD(R, kk) { const size_t kk_ = (size_t)(kk); R[0] = *(const u32x4*)(ksrc + kk_ * 256); R[1] = *(const u32x4*)(vsrc + kk_); }
#define A_STORE(R, buf) { bf16_t* sb_ = lds + (buf) * 2 * ATILE; *(u32x4*)(sb_ + st_off) = R[0]; *(u32x4*)(sb_ + ATILE + st_off) = R[1]; }
  f32x16 o[2][2];
#pragma unroll
  for (int a = 0; a < 2; ++a)
#pragma unroll
    for (int b = 0; b < 2; ++b)
#pragma unroll
      for (int i = 0; i < 16; ++i) o[a][b][i] = 0.f;
  float ls[2] = {0.f, 0.f};
  const int fo = swz(r) * AROW + 8 * h;
  const int nt = S >> 6;
#define A_COMPUTE(buf) { const bf16_t* kb_ = lds + (buf) * 2 * ATILE; const bf16_t* vb_ = kb_ + ATILE; \
    _Pragma("unroll") for (int kb = 0; kb < 2; ++kb) { \
      __builtin_amdgcn_sched_barrier(0); \
      bf16x8 kf[4], vf[2][2]; \
      _Pragma("unroll") for (int st = 0; st < 4; ++st) kf[st] = *(const bf16x8*)(kb_ + fo + kb * 32 * AROW + 16 * st); \
      _Pragma("unroll") for (int sp = 0; sp < 2; ++sp) _Pragma("unroll") for (int dt = 0; dt < 2; ++dt) vf[sp][dt] = *(const bf16x8*)(vb_ + fo + dt * 32 * AROW + kb * 32 + sp * 16); \
      f32x16 sx[2]; \
      _Pragma("unroll") for (int q2 = 0; q2 < 2; ++q2) _Pragma("unroll") for (int i = 0; i < 16; ++i) sx[q2][i] = negM; \
      __builtin_amdgcn_s_setprio(1); \
      _Pragma("unroll") for (int st = 0; st < 4; ++st) _Pragma("unroll") for (int q2 = 0; q2 < 2; ++q2) sx[q2] = __builtin_amdgcn_mfma_f32_32x32x16_bf16(kf[st], qf[q2][st], sx[q2], 0, 0, 0); \
      __builtin_amdgcn_s_setprio(0); \
      bf16x8 pf[2][2]; \
      _Pragma("unroll") for (int q2 = 0; q2 < 2; ++q2) { \
        _Pragma("unroll") for (int i = 0; i < 16; ++i) { sx[q2][i] = __builtin_amdgcn_exp2f(sx[q2][i]); ls[q2] += sx[q2][i]; } \
        _Pragma("unroll") for (int sp = 0; sp < 2; ++sp) { u32x4 pw; \
          pw.x = pk2(sx[q2][8 * sp + 0], sx[q2][8 * sp + 1]); pw.y = pk2(sx[q2][8 * sp + 2], sx[q2][8 * sp + 3]); \
          pw.z = pk2(sx[q2][8 * sp + 4], sx[q2][8 * sp + 5]); pw.w = pk2(sx[q2][8 * sp + 6], sx[q2][8 * sp + 7]); \
          pf[q2][sp] = __builtin_bit_cast(bf16x8, pw); } } \
      __builtin_amdgcn_s_setprio(1); \
      _Pragma("unroll") for (int sp = 0; sp < 2; ++sp) _Pragma("unroll") for (int dt = 0; dt < 2; ++dt) _Pragma("unroll") for (int q2 = 0; q2 < 2; ++q2) \
        o[q2][dt] = __builtin_amdgcn_mfma_f32_32x32x16_bf16(vf[sp][dt], pf[q2][sp], o[q2][dt], 0, 0, 0); \
      __builtin_amdgcn_s_setprio(0); } }
  A_LOAD(ta, 0);
  A_STORE(ta, 0);
  __syncthreads();
#pragma unroll 1
  for (int it = 0; it < nt; ++it) {
    const bool more = it + 1 < nt;
    if (more) A_LOAD(ta, (it + 1) * 64);
    __builtin_amdgcn_sched_barrier(0);
    const int bsel = it & 1;
    A_COMPUTE(bsel);
    __builtin_amdgcn_sched_barrier(0);
    if (more) A_STORE(ta, bsel ^ 1);
    __syncthreads();
  }
#undef A_LOAD
#undef A_STORE
#undef A_COMPUTE
  u32x4 zr[2][2][2];
#pragma unroll
  for (int q2 = 0; q2 < 2; ++q2)
#pragma unroll
    for (int dt = 0; dt < 2; ++dt)
#pragma unroll
      for (int run = 0; run < 2; ++run) zr[q2][dt][run] = *(const u32x4*)(p.sza + (size_t)(tq + 32 * q2) * D + head * 64 + 32 * dt + 16 * run + 8 * h);
  __builtin_amdgcn_sched_barrier(0);
#pragma unroll
  for (int q2 = 0; q2 < 2; ++q2) {
    float lsum = ls[q2];
    lsum += __shfl_xor(lsum, 32);
    const float inv = __frcp_rn(lsum);
#pragma unroll
    for (int dt = 0; dt < 2; ++dt)
#pragma unroll
      for (int run = 0; run < 2; ++run) {
        const size_t off = (size_t)(tq + 32 * q2) * D + head * 64 + 32 * dt + 16 * run + 8 * h;
        float w[8];
#pragma unroll
        for (int j = 0; j < 4; ++j) { const unsigned z = zr[q2][dt][run][j]; w[2 * j] = o[q2][dt][8 * run + 2 * j] * inv * bflo(z); w[2 * j + 1] = o[q2][dt][8 * run + 2 * j + 1] * inv * bfhi(z); }
        store8(p.Q + off, w);
      }
  }
}

__device__ void phase_ln(const Params& p, int row0, int nrows) {
  const int tid = TID, lane = tid & 63, wid = tid >> 6;
  f32x4 gg[4], bb[4];
#pragma unroll
  for (int i = 0; i < 4; ++i) { gg[i] = *(const f32x4*)(p.ln_g + i * 256 + lane * 4); bb[i] = *(const f32x4*)(p.ln_b + i * 256 + lane * 4); }
  constexpr int LNR = 4;
  for (int rr = (BID * (NTHR / 64) + wid) * LNR; rr < nrows; rr += gridDim.x * (NTHR / 64) * LNR) {
    float* row = p.out + (size_t)(row0 + rr) * D;
    f32x4 v[LNR][4];
    float s[LNR];
#pragma unroll
    for (int u = 0; u < LNR; ++u) s[u] = 0.f;
#pragma unroll
    for (int u = 0; u < LNR; ++u)
#pragma unroll
      for (int i = 0; i < 4; ++i) { v[u][i] = __builtin_nontemporal_load((const f32x4*)(row + u * D + i * 256 + lane * 4)); s[u] += (v[u][i].x + v[u][i].y) + (v[u][i].z + v[u][i].w); }
#pragma unroll
    for (int o = 32; o > 0; o >>= 1) {
#pragma unroll
      for (int u = 0; u < LNR; ++u) s[u] += __shfl_xor(s[u], o); }
#pragma unroll
    for (int u = 0; u < LNR; ++u) {
      const float mu = s[u] * (1.0f / D);
      float q = 0.f;
#pragma unroll
      for (int i = 0; i < 4; ++i) { v[u][i] = v[u][i] - mu; q += (v[u][i].x * v[u][i].x + v[u][i].y * v[u][i].y) + (v[u][i].z * v[u][i].z + v[u][i].w * v[u][i].w); }
#pragma unroll
      for (int o = 32; o > 0; o >>= 1) q += __shfl_xor(q, o);
      const float rstd = rsqrtf(q * (1.0f / D) + 1e-5f);
#pragma unroll
      for (int i = 0; i < 4; ++i) __builtin_nontemporal_store(v[u][i] * rstd * gg[i] + bb[i], (f32x4*)(row + u * D + i * 256 + lane * 4));
    }
  }
}

#define XB_TMO      128
#define XB_XCNT(j)  (256  + 64 * (j))
#define XB_XSUB(j)  (1280 + 64 * (j))
#define XB_XGEN(j)  (2304 + 64 * (j))
#define XB_TOP      3328
#define XB_TOPGEN   3392
#define XCD_BAR_WORDS 3456
#define XB_SPIN_CAP (1u << 22)
DI unsigned xb_ld(unsigned* p) { return __hip_atomic_load(p, __ATOMIC_RELAXED, __HIP_MEMORY_SCOPE_AGENT); }
DI unsigned xb_add(unsigned* p, unsigned v) { return __hip_atomic_fetch_add(p, v, __ATOMIC_RELAXED, __HIP_MEMORY_SCOPE_AGENT); }
DI unsigned xb_xcc_id() { return (unsigned)__builtin_amdgcn_s_getreg((3 << 11) | 20) & 0xFu; }
#define XB_SPIN(cond, bar) do { unsigned _sp = 0; while (cond) { __builtin_amdgcn_s_sleep(1); \
    if ((++_sp & 255u) == 0u) { if (xb_ld(&(bar)[XB_TMO])) break; if (_sp > XB_SPIN_CAP) { atomicAdd(&(bar)[XB_TMO], 1u); break; } } } } while (0)
DI void xcd_barrier_complete(unsigned* bar, unsigned x, unsigned& nloc, unsigned& nx) {
  const unsigned G = gridDim.x;
  unsigned sum, cnt, mine, sp = 0u;
  for (;;) {
    sum = 0u; cnt = 0u; mine = 0u;
#pragma unroll
    for (unsigned j = 0; j < 16; ++j) { const unsigned c = xb_ld(&bar[XB_XCNT(j)]); sum += c; cnt += (c > 0u) ? 1u : 0u; mine = (j == x) ? c : mine; }
    if (sum == G) break;
    __builtin_amdgcn_s_sleep(1);
    if ((++sp & 255u) == 0u) { if (xb_ld(&bar[XB_TMO])) break; if (sp > XB_SPIN_CAP) { atomicAdd(&bar[XB_TMO], 1u); break; } }
  }
  nloc = mine > 0u ? mine : 1u; nx = cnt > 0u ? cnt : 1u;
}
#define LAS __attribute__((address_space(3)))
DI void xcd_barrier(unsigned* bar, unsigned x, volatile LAS unsigned* st) {
  asm volatile("s_waitcnt vmcnt(0)" ::: "memory");
  __syncthreads();
  if (threadIdx.x == 0) {
    __builtin_amdgcn_s_waitcnt(0);
    unsigned nloc = st[0], nx = st[1];
    if (nloc == 0u) { xcd_barrier_complete(bar, x, nloc, nx); st[0] = nloc; st[1] = nx; }
    const unsigned old = xb_add(&bar[XB_XSUB(x)], 1u);
    const unsigned gen = old / nloc;
    if (old + 1u == (gen + 1u) * nloc) {
      __builtin_amdgcn_fence(__ATOMIC_RELEASE, "agent");
      asm volatile("s_waitcnt vmcnt(0)" ::: "memory");
      const unsigned og = xb_add(&bar[XB_TOP], 1u);
      const unsigned tg = og / nx;
      if (og + 1u == (tg + 1u) * nx) xb_add(&bar[XB_TOPGEN], 1u);
      else XB_SPIN(xb_ld(&bar[XB_TOPGEN]) == tg, bar);
      __builtin_amdgcn_fence(__ATOMIC_ACQUIRE, "agent");
      xb_add(&bar[XB_XGEN(x)], 1u);
      asm volatile("s_waitcnt vmcnt(0)" ::: "memory");
    } else {
      XB_SPIN(xb_ld(&bar[XB_XGEN(x)]) == gen, bar);
      __builtin_amdgcn_fence(__ATOMIC_ACQUIRE, "agent");
      asm volatile("s_waitcnt vmcnt(0)" ::: "memory");
    }
  }
  __syncthreads();
}

__device__ void run_phase(const Params& p, int ph, bf16_t* lds) {
  if (ph == 0) { phase_prep(p, lds); return; }
  if (ph == NPHASE - 1) { phase_ln(p, 16384, 32768); return; }
  const int c = (ph - 1) / 4, sub = (ph - 1) % 4, row0 = c ? 16384 : 0, nrows = c ? 32768 : 16384, S = c ? 4096 : 16384;
  const int lgmx = c ? 4 : 3, MX = 1 << lgmx, MT = 8 * MX;
  if (sub == 0) {
    const bf16_t* X = p.xb + (size_t)row0 * PX;
    for (int id = BID; id < 34 * MT; id += gridDim.x) {
      const int xcd = id & 7, j = id >> 3, n = j >> lgmx, m = MX * xcd + (j & (MX - 1));
      gemm_tile<EPI_INPROJ>(p, p.WinT, X, n, m, row0, S, lds);
    }
    if (c > 0) phase_ln(p, 0, 16384);
    else {
      const int G = gridDim.x, rem = (34 * MT) % G, b = BID;
      if (rem == 0) convert_x(p, 16384, T_ALL, b, G);
      else if (b >= rem) convert_x(p, 16384, T_ALL, b - rem, G - rem);
    }
  } else if (sub == 1) {
    const int nunits = nrows >> 5, UX = nunits >> 3;
    const bool conv_first = ((BID >> 3) & 1) != 0;
    if (conv_first) phase_conv(p, S, nrows);
    for (int id = BID; id < nunits; id += gridDim.x) attn_unit(p, S, UX * (id & 7) + (id >> 3), lds);
    if (!conv_first) phase_conv(p, S, nrows);
  } else if (sub == 2) {
    for (int id = BID; id < 4 * MT; id += gridDim.x) { const int j = id >> 3; gemm_tile<EPI_AOUT>(p, p.WaT, p.Q, j & 3, MX * (id & 7) + (j >> 2), row0, S, lds); }
  } else {
    for (int id = BID; id < 4 * MT; id += gridDim.x) { const int j = id >> 3; gemm_tile<EPI_OUT>(p, p.WoT, p.G, j & 3, MX * (id & 7) + (j >> 2), row0, S, lds); }
  }
}

__global__ void __launch_bounds__(NTHR, 2) mega(Params p, int ph_begin, int ph_end) {
  __shared__ __attribute__((aligned(16))) bf16_t lds[LDS_ELEMS];
  __shared__ uint4 xb_words;
  if (threadIdx.x == 0) xb_words = make_uint4(0u, 0u, 0u, 0u);
  __syncthreads();
  const unsigned xcc = xb_xcc_id();
  if (threadIdx.x == 0 && ph_end - ph_begin > 1) (void)xb_add(&p.bar[XB_XCNT(xcc)], 1u);
  if (ph_begin < 0) cg::this_grid().sync();
  for (int ph = ph_begin; ph < ph_end; ++ph) {
    run_phase(p, ph, lds);
    if (ph + 1 < ph_end) xcd_barrier(p.bar, xcc, (volatile LAS unsigned*)&xb_words);
  }
}

extern "C" void kernel_launch(void* const* d_in, const int* in_sizes, int n_in, void* d_out, int out_size, void* d_ws, size_t ws_size, hipStream_t stream) {
  static int grid_blocks = 0;
  if (!grid_blocks) {
    int dev = 0, cus = 0, per_cu = 0;
    hipGetDevice(&dev);
    hipDeviceGetAttribute(&cus, hipDeviceAttributeMultiprocessorCount, dev);
    hipOccupancyMaxActiveBlocksPerMultiprocessor(&per_cu, mega, NTHR, 0);
    if (per_cu > 1) per_cu = 1;
    if (per_cu < 1) per_cu = 1;
    if (per_cu > 4) per_cu = 4;
    grid_blocks = cus * per_cu;
  }
  Params p{};
  p.xp = (const float*)d_in[0]; p.xs = (const float*)d_in[1]; p.w_in = (const float*)d_in[2]; p.b_in = (const float*)d_in[3];
  p.q_gain = (const float*)d_in[4]; p.k_gain = (const float*)d_in[5]; p.conv_w = (const float*)d_in[6]; p.conv_b = (const float*)d_in[7];
  p.w_attn_out = (const float*)d_in[8]; p.w_conv_out = (const float*)d_in[9]; p.w_o = (const float*)d_in[10];
  p.ln_g = (const float*)d_in[11]; p.ln_b = (const float*)d_in[12];
  p.out = (float*)d_out;
  char* w = (char*)d_ws; size_t off = 0;
  auto take = [&](size_t bytes) { char* q = w + off; off += (bytes + 255) & ~(size_t)255; return q; };
  p.WinT = (bf16_t*)take((size_t)INW * PX * 2);
  p.WaT = (bf16_t*)take((size_t)D * D * 2); p.WcT = (bf16_t*)take((size_t)D * D * 2); p.WoT = (bf16_t*)take((size_t)D * D * 2);
  p.bias_v = (float*)take(INW * 4); p.tab_cos = (float*)take(256 * 16 * 4); p.tab_sin = (float*)take(256 * 16 * 4);
  p.xb = (bf16_t*)take((size_t)T_ALL * PX * 2);
  p.Q = (bf16_t*)take((size_t)CHMAX * D * 2); p.Kb = (bf16_t*)take((size_t)CHMAX * 256 * 2); p.Vt = (bf16_t*)take((size_t)CHMAX * 256 * 2);
  p.sza = (bf16_t*)take((size_t)CHMAX * D * 2); p.U = (bf16_t*)take((size_t)CHMAX * D * 2); p.G = (bf16_t*)take((size_t)CHMAX * D * 2);
  p.sga = (bf16_t*)take((size_t)CHMAX * D * 2); p.sgc = (bf16_t*)take((size_t)CHMAX * D * 2); p.conv = (bf16_t*)take((size_t)CHMAX * D * 2);
  p.mc = p.sgc;
  p.bar = (unsigned*)take(XCD_BAR_WORDS * 4);
  if (off > ws_size) { fprintf(stderr, "workspace too small: need %zu have %zu\n", off, ws_size); return; }
#if MK_SINGLE
  hipMemsetAsync(p.bar, 0, XCD_BAR_WORDS * 4, stream);
  int b = 0, e = NPHASE;
  void* args[] = {&p, &b, &e};
  hipError_t err = hipLaunchCooperativeKernel((void*)mega, dim3(grid_blocks), dim3(NTHR), args, 0, stream);
  if (err != hipSuccess) fprintf(stderr, "cooperative launch failed: %s (grid %d)\n", hipGetErrorString(err), grid_blocks);
#else
  for (int ph = 0; ph < NPHASE; ++ph) hipLaunchKernelGGL(mega, dim3(grid_blocks), dim3(NTHR), 0, stream, p, ph, ph + 1);
#endif
}
```

```cpp
#include <hip/hip_runtime.h>
#include <hip/hip_cooperative_groups.h>
#include <cstdio>
#include <cstdint>
namespace cg = cooperative_groups;

#ifndef ATT_C
#define ATT_C 1.0f
#endif
#ifndef OSC
#define OSC 1.0f
#endif
#ifndef MK_SINGLE
#define MK_SINGLE 1
#endif

typedef unsigned short bf16_t;
typedef short bf16x8 __attribute__((ext_vector_type(8)));
typedef float f32x16 __attribute__((ext_vector_type(16)));
typedef float f32x4 __attribute__((ext_vector_type(4)));
typedef float f32x2 __attribute__((ext_vector_type(2)));
typedef unsigned u32x4 __attribute__((ext_vector_type(4)));
typedef __bf16 bf16x2_t __attribute__((ext_vector_type(2)));
#define DI __device__ __forceinline__
DI int opq_v(int t) { asm volatile("" : "+v"(t)); return t; }
DI int opq_s(int t) { asm volatile("" : "+s"(t)); return t; }
#define TID (opq_v((int)threadIdx.x))
#define BID (opq_s((int)blockIdx.x))

constexpr int D = 1024, INW = 8704, T_ALL = 49152, CHMAX = 32768;
constexpr int BK = 64, LROW = BK + 8, WT = 256 * LROW, XT = 256 * LROW, GBUF = WT + XT;
constexpr int AROW = 72, ATILE = 64 * AROW;
constexpr int SROWE = 72, STG = 32 * SROWE;
constexpr int LDS_ELEMS = (GBUF > 4 * ATILE ? GBUF : 4 * ATILE) + 8 * STG;
constexpr float QSCALE = 0.125f * 1.4426950408889634f;
constexpr float DN_ALPHA = 1.189207115002721f;
constexpr int NPHASE = 10;
constexpr int NTHR = 512;
constexpr int PX = 1088;

struct Params {
  const float* xp; const float* xs; const float* w_in; const float* b_in; const float* q_gain; const float* k_gain;
  const float* conv_w; const float* conv_b; const float* w_attn_out; const float* w_conv_out; const float* w_o;
  const float* ln_g; const float* ln_b;
  float* out;
  bf16_t* WinT; bf16_t* WaT; bf16_t* WcT; bf16_t* WoT; float* bias_v; float* tab_cos; float* tab_sin;
  bf16_t* xb; bf16_t* Q; bf16_t* Kb; bf16_t* Vt; bf16_t* sza; bf16_t* U; bf16_t* G; bf16_t* sga; bf16_t* sgc; bf16_t* conv; bf16_t* mc;
  unsigned* bar;
};

DI unsigned pk2(float lo, float hi) { f32x2 v = {lo, hi}; return __builtin_bit_cast(unsigned, __builtin_convertvector(v, bf16x2_t)); }
DI float bf2f(unsigned short x) { return __uint_as_float(((unsigned)x) << 16); }
DI float bflo(unsigned w) { return __uint_as_float(w << 16); }
DI float bfhi(unsigned w) { return __uint_as_float(w & 0xffff0000u); }
DI int swz(int r) { return (r & ~12) | ((r & 4) << 1) | ((r & 8) >> 1); }
DI float sigmoidf_(float z) { return __builtin_amdgcn_rcpf(1.0f + __builtin_amdgcn_exp2f(-1.4426950408889634f * z)); }
DI float siluf_(float z) { return z * sigmoidf_(z); }
DI void store8(bf16_t* dst, const float* v) {
  u32x4 w; w.x = pk2(v[0], v[1]); w.y = pk2(v[2], v[3]); w.z = pk2(v[4], v[5]); w.w = pk2(v[6], v[7]);
  *(u32x4*)dst = w;
}
DI void load8(const bf16_t* src, float* v) {
  u32x4 w = *(const u32x4*)src;
  v[0] = bflo(w.x); v[1] = bfhi(w.x); v[2] = bflo(w.y); v[3] = bfhi(w.y); v[4] = bflo(w.z); v[5] = bfhi(w.z); v[6] = bflo(w.w); v[7] = bfhi(w.w);
}
DI void load8f_nt(const float* src, float* v) {
  f32x4 a = __builtin_nontemporal_load((const f32x4*)src), b = __builtin_nontemporal_load((const f32x4*)(src + 4));
  v[0] = a.x; v[1] = a.y; v[2] = a.z; v[3] = a.w; v[4] = b.x; v[5] = b.y; v[6] = b.z; v[7] = b.w;
}
DI void load8f(const float* src, float* v) {
  f32x4 a = *(const f32x4*)src, b = *(const f32x4*)(src + 4);
  v[0] = a.x; v[1] = a.y; v[2] = a.z; v[3] = a.w; v[4] = b.x; v[5] = b.y; v[6] = b.z; v[7] = b.w;
}
DI int vcol(int v) {
  const int g = v >> 6, ni = (v >> 5) & 1, f = v & 31;
  if (g >= 40 && g < 72) { const int cb = g - 40; return (ni ? 4608 : 3584) + 32 * cb + f; }
  if (g >= 72 && g < 104) { const int cb = g - 72; return (ni ? 5632 : 2560) + 32 * cb + f; }
  return v;
}
DI const float* xrow(const Params& p, int R) { return R < 16384 ? p.xp + (size_t)R * D : p.xs + (size_t)(R - 16384) * D; }

__device__ void convert_x(const Params& p, int r0, int r1, int bidx, int nblk) {
  const int gt = bidx * NTHR + TID, gn = nblk * NTHR, i0 = r0 * (D / 8), i1 = r1 * (D / 8);
  for (int i = i0 + gt; i < i1; i += 4 * gn) {
    float v[4][8];
#pragma unroll
    for (int u = 0; u < 4; ++u) { const int ii = i + u * gn; if (ii < i1) load8f_nt(xrow(p, ii >> 7) + (ii & 127) * 8, v[u]); }
#pragma unroll
    for (int u = 0; u < 4; ++u) { const int ii = i + u * gn; if (ii < i1) store8(p.xb + (size_t)(ii >> 7) * PX + (ii & 127) * 8, v[u]); }
  }
}

__device__ void transpose_w(const float* __restrict__ src, int ldsrc, bf16_t* __restrict__ dst, int lddst, int ng32, bool virt, bf16_t* lds) {
  const int tid = TID;
  constexpr int TP = 136;
  for (int tile = BID; tile < ng32 * 8; tile += gridDim.x) {
    const int cgp = tile % ng32, kb = tile / ng32, v0 = cgp * 32, col0 = virt ? vcol(v0) : v0, k0 = kb * 128;
    f32x4 x[2];
#pragma unroll
    for (int ps = 0; ps < 2; ++ps) x[ps] = __builtin_nontemporal_load((const f32x4*)(src + (size_t)(k0 + ps * 64 + (tid >> 3)) * ldsrc + col0 + (tid & 7) * 4));
#pragma unroll
    for (int ps = 0; ps < 2; ++ps)
#pragma unroll
      for (int j = 0; j < 4; ++j) lds[((tid & 7) * 4 + j) * TP + ps * 64 + (tid >> 3)] = (bf16_t)(pk2(x[ps][j], 0.f) & 0xffffu);
    __syncthreads();
    const u32x4 w = *(const u32x4*)(lds + (tid >> 4) * TP + (tid & 15) * 8);
    *(u32x4*)(dst + (size_t)(v0 + (tid >> 4)) * lddst + k0 + (tid & 15) * 8) = w;
    __syncthreads();
  }
}

__device__ void phase_prep(const Params& p, bf16_t* lds) {
  const int gt = BID * NTHR + TID, gn = gridDim.x * NTHR;
  convert_x(p, 0, 16384, BID, gridDim.x);
  transpose_w(p.w_in, INW, p.WinT, PX, INW / 32, true, lds);
  transpose_w(p.w_attn_out, D, p.WaT, D, D / 32, false, lds);
  transpose_w(p.w_conv_out, D, p.WcT, D, D / 32, false, lds);
  transpose_w(p.w_o, D, p.WoT, D, D / 32, false, lds);
  for (int i = gt; i < INW; i += gn) p.bias_v[i] = p.b_in[vcol(i)];
  for (int i = gt; i < 256 * 16; i += gn) {
    const int pos = i >> 4, f = i & 15;
    const float inv = powf(10000.0f, -(float)(2 * f) / 32.0f);
    const float ang = (float)pos * inv;
    p.tab_cos[i] = cosf(ang); p.tab_sin[i] = sinf(ang);
  }
}

enum { EPI_INPROJ = 0, EPI_CONV = 1, EPI_AOUT = 2, EPI_OUT = 3 };

template <int NCH>
DI void flush_rows(const bf16_t* wlt, bf16_t* dst0, int pitch, int lane) {
  constexpr int RPP = 64 / NCH;
#pragma unroll
  for (int ps = 0; ps < 32 / RPP; ++ps) {
    const int row = ps * RPP + lane / NCH, c = lane % NCH;
    const u32x4 w = *(const u32x4*)(wlt + row * SROWE + c * 8);
    *(u32x4*)(dst0 + (size_t)row * pitch + c * 8) = w;
  }
}

template <int EPI>
__device__ void gemm_tile(const Params& p, const bf16_t* __restrict__ Wt, const bf16_t* __restrict__ X, int tile_n, int tile_m, int row0, int S, bf16_t* lds) {
  constexpr int LDW = EPI == EPI_INPROJ ? PX : D, LDX = EPI == EPI_INPROJ ? PX : D;
  const int tid = TID, lane = tid & 63, wid = tid >> 6, wn = wid >> 1, wm = wid & 1, r = lane & 31, h = lane >> 5;
  const int lrow = tid >> 3, lkc = tid & 7;
  const bf16_t* wsrc = Wt + (size_t)(tile_n * 256 + lrow) * LDW + lkc * 8;
  const bf16_t* xsrc = X + (size_t)(tile_m * 256 + lrow) * LDX + lkc * 8;
  const int gq_ = tile_n * 4 + wn;
  const int st_off = lrow * LROW + lkc * 8;
  f32x16 acc[2][4];
#pragma unroll
  for (int a = 0; a < 2; ++a)
#pragma unroll
    for (int b = 0; b < 4; ++b)
#pragma unroll
      for (int i = 0; i < 16; ++i) acc[a][b][i] = 0.f;
  u32x4 rg[8];
#define G_LOAD(k0) { _Pragma("unroll") for (int i = 0; i < 4; ++i) rg[i] = *(const u32x4*)(wsrc + (size_t)i * 64 * LDW + (k0)); \
                     _Pragma("unroll") for (int i = 0; i < 4; ++i) rg[4 + i] = *(const u32x4*)(xsrc + (size_t)i * 64 * LDX + (k0)); }
#define G_STORE() { _Pragma("unroll") for (int i = 0; i < 4; ++i) *(u32x4*)(lds + st_off + i * 64 * LROW) = rg[i]; \
                    _Pragma("unroll") for (int i = 0; i < 4; ++i) *(u32x4*)(lds + WT + st_off + i * 64 * LROW) = rg[4 + i]; }
  const int wfo = (wn * 64 + swz(r)) * LROW + 8 * h;
  const int xfo = WT + (wm * 128 + r) * LROW + 8 * h;
  constexpr int NK = D / BK;
#pragma unroll 1
  for (int pass = 0; pass < (EPI == EPI_AOUT ? 2 : 1); ++pass) {
  if (EPI == EPI_AOUT && pass == 1) {
    wsrc = p.WcT + (size_t)(tile_n * 256 + lrow) * D + lkc * 8; xsrc = p.conv + (size_t)(tile_m * 256 + lrow) * D + lkc * 8;
#pragma unroll
    for (int mb = 0; mb < 2; ++mb) {
      u32x4 ra[2][2][2], rc[2][2][2];
#pragma unroll
      for (int m2 = 0; m2 < 2; ++m2)
#pragma unroll
        for (int ni = 0; ni < 2; ++ni)
#pragma unroll
          for (int run = 0; run < 2; ++run) {
            const size_t off = (size_t)(tile_m * 256 + wm * 128 + (2 * mb + m2) * 32 + r) * D + 64 * gq_ + 32 * ni + 16 * run + 8 * h;
            ra[m2][ni][run] = *(const u32x4*)(p.sga + off); rc[m2][ni][run] = *(const u32x4*)(p.sgc + off);
          }
      __builtin_amdgcn_sched_barrier(0);
#pragma unroll
      for (int m2 = 0; m2 < 2; ++m2)
#pragma unroll
        for (int ni = 0; ni < 2; ++ni)
#pragma unroll
          for (int run = 0; run < 2; ++run)
#pragma unroll
            for (int j = 0; j < 4; ++j) {
              const unsigned wa = ra[m2][ni][run][j], wc = rc[m2][ni][run][j];
              acc[ni][2 * mb + m2][8 * run + 2 * j] *= bflo(wa) * __builtin_amdgcn_rcpf(fmaxf(bflo(wc), 1e-30f));
              acc[ni][2 * mb + m2][8 * run + 2 * j + 1] *= bfhi(wa) * __builtin_amdgcn_rcpf(fmaxf(bfhi(wc), 1e-30f));
            }
      __builtin_amdgcn_sched_barrier(0);
    }
  }
  G_LOAD(0);
#pragma unroll 1
  for (int kt = 0; kt < NK; ++kt) {
    G_STORE();
    __syncthreads();
    if (kt + 1 < NK) G_LOAD((kt + 1) * BK);
    __builtin_amdgcn_sched_barrier(0);
#pragma unroll
    for (int ks = 0; ks < 4; ++ks) {
      bf16x8 wf[2], xf[4];
#pragma unroll
      for (int ni = 0; ni < 2; ++ni) wf[ni] = *(const bf16x8*)(lds + wfo + ni * 32 * LROW + ks * 16);
#pragma unroll
      for (int mi = 0; mi < 4; ++mi) xf[mi] = *(const bf16x8*)(lds + xfo + mi * 32 * LROW + ks * 16);
      __builtin_amdgcn_s_setprio(1);
#pragma unroll
      for (int ni = 0; ni < 2; ++ni)
#pragma unroll
        for (int mi = 0; mi < 4; ++mi) acc[ni][mi] = __builtin_amdgcn_mfma_f32_32x32x16_bf16(wf[ni], xf[mi], acc[ni][mi], 0, 0, 0);
      __builtin_amdgcn_s_setprio(0);
    }
    __builtin_amdgcn_sched_barrier(0);
    __syncthreads();
  }
  }
#undef G_LOAD
#undef G_STORE

  const int g = tile_n * 4 + wn;
  bf16_t* const wlt = lds + (GBUF > 4 * ATILE ? GBUF : 4 * ATILE) + wid * STG;
  bf16_t* const wl = wlt + r * SROWE;
  if (EPI == EPI_INPROJ) {
    {
      float bz[2][16];
#pragma unroll
      for (int ni = 0; ni < 2; ++ni)
#pragma unroll
        for (int run = 0; run < 2; ++run) load8f(p.bias_v + 64 * g + 32 * ni + 16 * run + 8 * h, &bz[ni][8 * run]);
      __builtin_amdgcn_sched_barrier(0);
#pragma unroll
      for (int mi = 0; mi < 4; ++mi)
#pragma unroll
        for (int ni = 0; ni < 2; ++ni)
#pragma unroll
          for (int i = 0; i < 16; ++i) acc[ni][mi][i] += bz[ni][i];
    }
    if (g < 20) {
      const float* gain = g < 16 ? p.q_gain : p.k_gain;
      const float osc = g < 16 ? QSCALE : 1.0f;
      float gn[2][16];
#pragma unroll
      for (int ni = 0; ni < 2; ++ni) { load8f(gain + 32 * ni + 8 * h, &gn[ni][0]); load8f(gain + 32 * ni + 16 + 8 * h, &gn[ni][8]); }
#pragma unroll
      for (int mi = 0; mi < 4; ++mi) {
        const int tl = tile_m * 256 + wm * 128 + mi * 32 + r, t = tl & (S - 1);
        float cs[2][8], sn[2][8];
#pragma unroll
        for (int ni = 0; ni < 2; ++ni) { const int pos = ni ? (t & 63) : (t >> 6); load8f(p.tab_cos + pos * 16 + 8 * h, cs[ni]); load8f(p.tab_sin + pos * 16 + 8 * h, sn[ni]); }
        float ss = 0.f;
#pragma unroll
        for (int ni = 0; ni < 2; ++ni)
#pragma unroll
          for (int i = 0; i < 16; ++i) ss += acc[ni][mi][i] * acc[ni][mi][i];
        ss += __shfl_xor(ss, 32);
        const float rinv = rsqrtf(ss * (1.0f / 64.0f) + 1e-6f);
        const int tl0 = tile_m * 256 + wm * 128 + mi * 32;
        bf16_t* dst0 = g < 16 ? p.Q + (size_t)tl0 * D + 64 * g : p.Kb + (size_t)tl0 * 256 + 64 * (g - 16);
#pragma unroll
        for (int ni = 0; ni < 2; ++ni) {
          float o1[8], o2[8];
#pragma unroll
          for (int j = 0; j < 8; ++j) {
            const float a = acc[ni][mi][j] * rinv * gn[ni][j], b = acc[ni][mi][8 + j] * rinv * gn[ni][8 + j];
            o1[j] = (a * cs[ni][j] - b * sn[ni][j]) * osc; o2[j] = (b * cs[ni][j] + a * sn[ni][j]) * osc;
          }
          store8(wl + 32 * ni + 8 * h, o1); store8(wl + 32 * ni + 16 + 8 * h, o2);
        }
        flush_rows<8>(wlt, dst0, g < 16 ? D : 256, lane);
      }
    } else {
#pragma unroll
      for (int mi = 0; mi < 4; ++mi) {
        const int tl = tile_m * 256 + wm * 128 + mi * 32 + r;
        if (g < 24) {
          const int kvh = g - 20, sl = tl / S, t = tl & (S - 1);
          bf16_t* dst = p.Vt + (size_t)((sl * 4 + kvh) * 64) * S + t;
#pragma unroll
          for (int ni = 0; ni < 2; ++ni)
#pragma unroll
            for (int i = 0; i < 16; ++i) {
              const int d = 32 * ni + (i & 7) + 8 * h + 16 * (i >> 3);
              dst[(size_t)d * S] = (bf16_t)(pk2(acc[ni][mi][i], 0.f) & 0xffffu);
            }
        } else if (g < 40) {
          bf16_t* dst0 = p.sza + (size_t)(tl - r) * D + 64 * (g - 24);
#pragma unroll
          for (int ni = 0; ni < 2; ++ni)
#pragma unroll
            for (int run = 0; run < 2; ++run) {
              float o[8];
#pragma unroll
              for (int j = 0; j < 8; ++j) o[j] = siluf_(acc[ni][mi][8 * run + j]);
              store8(wl + 32 * ni + 16 * run + 8 * h, o);
            }
          flush_rows<8>(wlt, dst0, D, lane);
        } else if (g < 104) {
          const bool isU = g < 72;
          bf16_t* dst0 = (isU ? p.U + 32 * (g - 40) : p.G + 32 * (g - 72)) + (size_t)(tl - r) * D;
#pragma unroll
          for (int run = 0; run < 2; ++run) {
            float o[8];
#pragma unroll
            for (int j = 0; j < 8; ++j) o[j] = isU ? acc[0][mi][8 * run + j] * acc[1][mi][8 * run + j] : acc[0][mi][8 * run + j] * siluf_(acc[1][mi][8 * run + j]);
            store8(wl + 16 * run + 8 * h, o);
          }
          flush_rows<4>(wlt, dst0, D, lane);
        } else {
          bf16_t* dst0 = (g < 120 ? p.sga + 64 * (g - 104) : p.sgc + 64 * (g - 120)) + (size_t)(tl - r) * D;
#pragma unroll
          for (int ni = 0; ni < 2; ++ni)
#pragma unroll
            for (int run = 0; run < 2; ++run) {
              float o[8];
#pragma unroll
              for (int j = 0; j < 8; ++j) o[j] = sigmoidf_(acc[ni][mi][8 * run + j]);
              store8(wl + 32 * ni + 16 * run + 8 * h, o);
            }
          flush_rows<8>(wlt, dst0, D, lane);
        }
      }
    }
  }
  if (EPI == EPI_AOUT) {
    u32x4 rc[4][2][2];
#pragma unroll
    for (int mi = 0; mi < 4; ++mi)
#pragma unroll
      for (int ni = 0; ni < 2; ++ni)
#pragma unroll
        for (int run = 0; run < 2; ++run)
          rc[mi][ni][run] = *(const u32x4*)(p.sgc + (size_t)(tile_m * 256 + wm * 128 + mi * 32 + r) * D + 64 * g + 32 * ni + 16 * run + 8 * h);
    __builtin_amdgcn_sched_barrier(0);
#pragma unroll
    for (int mi = 0; mi < 4; ++mi)
#pragma unroll
      for (int ni = 0; ni < 2; ++ni)
#pragma unroll
        for (int run = 0; run < 2; ++run) {
          float o[8];
#pragma unroll
          for (int j = 0; j < 4; ++j) { const unsigned wc = rc[mi][ni][run][j]; o[2 * j] = acc[ni][mi][8 * run + 2 * j] * bflo(wc); o[2 * j + 1] = acc[ni][mi][8 * run + 2 * j + 1] * bfhi(wc); }
          store8(p.G + (size_t)(tile_m * 256 + wm * 128 + mi * 32 + r) * D + 64 * g + 32 * ni + 16 * run + 8 * h, o);
        }
  }
  if (EPI == EPI_OUT) {
#pragma unroll
    for (int mb = 0; mb < 2; ++mb) {
      f32x4 xr[2][2][2][2];
#pragma unroll
      for (int m2 = 0; m2 < 2; ++m2)
#pragma unroll
        for (int ni = 0; ni < 2; ++ni)
#pragma unroll
          for (int run = 0; run < 2; ++run) {
            const int tl = tile_m * 256 + wm * 128 + (2 * mb + m2) * 32 + r;
            const float* xp_ = xrow(p, row0 + tl) + 64 * g + 32 * ni + 16 * run + 8 * h;
            xr[m2][ni][run][0] = *(const f32x4*)xp_; xr[m2][ni][run][1] = *(const f32x4*)(xp_ + 4);
          }
      __builtin_amdgcn_sched_barrier(0);
#pragma unroll
      for (int m2 = 0; m2 < 2; ++m2)
#pragma unroll
        for (int ni = 0; ni < 2; ++ni)
#pragma unroll
          for (int run = 0; run < 2; ++run) {
            const int mi = 2 * mb + m2, tl = tile_m * 256 + wm * 128 + mi * 32 + r;
            float* dst = p.out + (size_t)(row0 + tl) * D + 64 * g + 32 * ni + 16 * run + 8 * h;
            f32x4 a, b;
#pragma unroll
            for (int j = 0; j < 4; ++j) { a[j] = DN_ALPHA * xr[m2][ni][run][0][j] + acc[ni][mi][8 * run + j]; b[j] = DN_ALPHA * xr[m2][ni][run][1][j] + acc[ni][mi][8 * run + 4 + j]; }
            *(f32x4*)dst = a; *(f32x4*)(dst + 4) = b;
          }
      __builtin_amdgcn_sched_barrier(0);
    }
  }
}

__device__ void phase_conv(const Params& p, int S, int nrows) {
  const int gt = BID * NTHR + TID, gn = gridDim.x * NTHR;
  for (int i = gt; i < (nrows >> 2) * 128; i += gn) {
    const int tl0 = (i >> 7) * 4, c8 = (i & 127) * 8, t0 = tl0 & (S - 1);
    float u[6][8], gg[4][8], w0[8], w1[8], w2[8], b[8];
    const bf16_t* up_ = p.U + (size_t)tl0 * D + c8;
    if (t0 > 0) load8(up_ - D, u[0]); else {
#pragma unroll
      for (int j = 0; j < 8; ++j) u[0][j] = 0.f; }
#pragma unroll
    for (int k = 0; k < 4; ++k) load8(up_ + (size_t)k * D, u[k + 1]);
    if (t0 + 4 < S) load8(up_ + (size_t)4 * D, u[5]); else {
#pragma unroll
      for (int j = 0; j < 8; ++j) u[5][j] = 0.f; }
#pragma unroll
    for (int k = 0; k < 4; ++k) load8(p.G + (size_t)(tl0 + k) * D + c8, gg[k]);
    load8f(p.conv_w + c8, w0); load8f(p.conv_w + D + c8, w1); load8f(p.conv_w + 2 * D + c8, w2); load8f(p.conv_b + c8, b);
#pragma unroll
    for (int k = 0; k < 4; ++k) {
      float o[8];
#pragma unroll
      for (int j = 0; j < 8; ++j) o[j] = gg[k][j] * (w0[j] * u[k][j] + w1[j] * u[k + 1][j] + w2[j] * u[k + 2][j] + b[j]);
      store8(p.conv + (size_t)(tl0 + k) * D + c8, o);
    }
  }
}

__device__ void attn_unit(const Params& p, int S, int unit, bf16_t* lds) {
  const int tid = TID, lane = tid & 63, wid = tid >> 6, r = lane & 31, h = lane >> 5;
  const int nqb = S >> 9;
  const int qb = unit % nqb, hq4 = (unit / nqb) & 3, kvh = (unit / (4 * nqb)) & 3, sl = unit / (16 * nqb);
  const int head = kvh * 4 + hq4;
  float gq = fabsf(p.q_gain[lane]), gk = fabsf(p.k_gain[lane]);
#pragma unroll
  for (int o = 32; o > 0; o >>= 1) { gq = fmaxf(gq, __shfl_xor(gq, o)); gk = fmaxf(gk, __shfl_xor(gk, o)); }
  const float negM = -(64.0f * gq * gk * QSCALE * 1.02f);
  const int tq = sl * S + qb * 512 + wid * 64 + r;
  bf16x8 qf[2][4];
#pragma unroll
  for (int q2 = 0; q2 < 2; ++q2)
#pragma unroll
    for (int st = 0; st < 4; ++st) qf[q2][st] = *(const bf16x8*)(p.Q + (size_t)(tq + 32 * q2) * D + head * 64 + 16 * st + 8 * h);
  const bf16_t* Kg = p.Kb + (size_t)(sl * S) * 256 + kvh * 64;
  const bf16_t* Vg = p.Vt + (size_t)((sl * 4 + kvh) * 64) * S;
  const int lr = tid >> 3, lc = (tid & 7) * 8;
  const bf16_t* ksrc = Kg + (size_t)lr * 256 + lc;
  const bf16_t* vsrc = Vg + (size_t)lr * S + lc;
  const int st_off = lr * AROW + lc;
  u32x4 ta[2];
#define A_LOAD(R, kk) { const size_t kk_ = (size_t)(kk); R[0] = *(const u32x4*)(ksrc + kk_ * 256); R[1] = *(const u32x4*)(vsrc + kk_); }
#define A_STORE(R, buf) { bf16_t* sb_ = lds + (buf) * 2 * ATILE; *(u32x4*)(sb_ + st_off) = R[0]; *(u32x4*)(sb_ + ATILE + st_off) = R[1]; }
  f32x16 o[2][2];
#pragma unroll
  for (int a = 0; a < 2; ++a)
#pragma unroll
    for (int b = 0; b < 2; ++b)
#pragma unroll
      for (int i = 0; i < 16; ++i) o[a][b][i] = 0.f;
  float ls[2] = {0.f, 0.f};
  f32x16 negMv;
#pragma unroll
  for (int i = 0; i < 16; ++i) negMv[i] = negM;
  const int fo = swz(r) * AROW + 8 * h;
  const int nt = S >> 6;
#define A_COMPUTE(buf) { const bf16_t* kb_ = lds + (buf) * 2 * ATILE; const bf16_t* vb_ = kb_ + ATILE; \
    _Pragma("unroll") for (int kb = 0; kb < 2; ++kb) { \
      __builtin_amdgcn_sched_barrier(0); \
      bf16x8 kf[4], vf[2][2]; \
      _Pragma("unroll") for (int st = 0; st < 4; ++st) kf[st] = *(const bf16x8*)(kb_ + fo + kb * 32 * AROW + 16 * st); \
      _Pragma("unroll") for (int sp = 0; sp < 2; ++sp) _Pragma("unroll") for (int dt = 0; dt < 2; ++dt) vf[sp][dt] = *(const bf16x8*)(vb_ + fo + dt * 32 * AROW + kb * 32 + sp * 16); \
      f32x16 sx[2]; \
      __builtin_amdgcn_s_setprio(1); \
      _Pragma("unroll") for (int q2 = 0; q2 < 2; ++q2) sx[q2] = __builtin_amdgcn_mfma_f32_32x32x16_bf16(kf[0], qf[q2][0], negMv, 0, 0, 0); \
      _Pragma("unroll") for (int st = 1; st < 4; ++st) _Pragma("unroll") for (int q2 = 0; q2 < 2; ++q2) sx[q2] = __builtin_amdgcn_mfma_f32_32x32x16_bf16(kf[st], qf[q2][st], sx[q2], 0, 0, 0); \
      __builtin_amdgcn_s_setprio(0); \
      bf16x8 pf[2][2]; \
      _Pragma("unroll") for (int q2 = 0; q2 < 2; ++q2) { \
        _Pragma("unroll") for (int i = 0; i < 16; ++i) { sx[q2][i] = __builtin_amdgcn_exp2f(sx[q2][i]); ls[q2] += sx[q2][i]; } \
        _Pragma("unroll") for (int sp = 0; sp < 2; ++sp) { u32x4 pw; \
          pw.x = pk2(sx[q2][8 * sp + 0], sx[q2][8 * sp + 1]); pw.y = pk2(sx[q2][8 * sp + 2], sx[q2][8 * sp + 3]); \
          pw.z = pk2(sx[q2][8 * sp + 4], sx[q2][8 * sp + 5]); pw.w = pk2(sx[q2][8 * sp + 6], sx[q2][8 * sp + 7]); \
          pf[q2][sp] = __builtin_bit_cast(bf16x8, pw); } } \
      __builtin_amdgcn_s_setprio(1); \
      _Pragma("unroll") for (int sp = 0; sp < 2; ++sp) _Pragma("unroll") for (int dt = 0; dt < 2; ++dt) _Pragma("unroll") for (int q2 = 0; q2 < 2; ++q2) \
        o[q2][dt] = __builtin_amdgcn_mfma_f32_32x32x16_bf16(vf[sp][dt], pf[q2][sp], o[q2][dt], 0, 0, 0); \
      __builtin_amdgcn_s_setprio(0); } }
  A_LOAD(ta, 0);
  A_STORE(ta, 0);
  __syncthreads();
#pragma unroll 1
  for (int it = 0; it < nt; ++it) {
    const bool more = it + 1 < nt;
    if (more) A_LOAD(ta, (it + 1) * 64);
    __builtin_amdgcn_sched_barrier(0);
    const int bsel = it & 1;
    A_COMPUTE(bsel);
    __builtin_amdgcn_sched_barrier(0);
    if (more) A_STORE(ta, bsel ^ 1);
    __syncthreads();
  }
#undef A_LOAD
#undef A_STORE
#undef A_COMPUTE
  u32x4 zr[2][2][2];
#pragma unroll
  for (int q2 = 0; q2 < 2; ++q2)
#pragma unroll
    for (int dt = 0; dt < 2; ++dt)
#pragma unroll
      for (int run = 0; run < 2; ++run) zr[q2][dt][run] = *(const u32x4*)(p.sza + (size_t)(tq + 32 * q2) * D + head * 64 + 32 * dt + 16 * run + 8 * h);
  __builtin_amdgcn_sched_barrier(0);
#pragma unroll
  for (int q2 = 0; q2 < 2; ++q2) {
    float lsum = ls[q2];
    lsum += __shfl_xor(lsum, 32);
    const float inv = __frcp_rn(lsum);
#pragma unroll
    for (int dt = 0; dt < 2; ++dt)
#pragma unroll
      for (int run = 0; run < 2; ++run) {
        const size_t off = (size_t)(tq + 32 * q2) * D + head * 64 + 32 * dt + 16 * run + 8 * h;
        float w[8];
#pragma unroll
        for (int j = 0; j < 4; ++j) { const unsigned z = zr[q2][dt][run][j]; w[2 * j] = o[q2][dt][8 * run + 2 * j] * inv * bflo(z); w[2 * j + 1] = o[q2][dt][8 * run + 2 * j + 1] * inv * bfhi(z); }
        store8(p.Q + off, w);
      }
  }
}

__device__ void phase_ln(const Params& p, int row0, int nrows) {
  const int tid = TID, lane = tid & 63, wid = tid >> 6;
  f32x4 gg[4], bb[4];
#pragma unroll
  for (int i = 0; i < 4; ++i) { gg[i] = *(const f32x4*)(p.ln_g + i * 256 + lane * 4); bb[i] = *(const f32x4*)(p.ln_b + i * 256 + lane * 4); }
  constexpr int LNR = 4;
  for (int rr = (BID * (NTHR / 64) + wid) * LNR; rr < nrows; rr += gridDim.x * (NTHR / 64) * LNR) {
    float* row = p.out + (size_t)(row0 + rr) * D;
    f32x4 v[LNR][4];
    float s[LNR];
#pragma unroll
    for (int u = 0; u < LNR; ++u) s[u] = 0.f;
#pragma unroll
    for (int u = 0; u < LNR; ++u)
#pragma unroll
      for (int i = 0; i < 4; ++i) { v[u][i] = __builtin_nontemporal_load((const f32x4*)(row + u * D + i * 256 + lane * 4)); s[u] += (v[u][i].x + v[u][i].y) + (v[u][i].z + v[u][i].w); }
#pragma unroll
    for (int o = 32; o > 0; o >>= 1) {
#pragma unroll
      for (int u = 0; u < LNR; ++u) s[u] += __shfl_xor(s[u], o); }
#pragma unroll
    for (int u = 0; u < LNR; ++u) {
      const float mu = s[u] * (1.0f / D);
      float q = 0.f;
#pragma unroll
      for (int i = 0; i < 4; ++i) { v[u][i] = v[u][i] - mu; q += (v[u][i].x * v[u][i].x + v[u][i].y * v[u][i].y) + (v[u][i].z * v[u][i].z + v[u][i].w * v[u][i].w); }
#pragma unroll
      for (int o = 32; o > 0; o >>= 1) q += __shfl_xor(q, o);
      const float rstd = rsqrtf(q * (1.0f / D) + 1e-5f);
#pragma unroll
      for (int i = 0; i < 4; ++i) __builtin_nontemporal_store(v[u][i] * rstd * gg[i] + bb[i], (f32x4*)(row + u * D + i * 256 + lane * 4));
    }
  }
}

#define XB_TMO      128
#define XB_XCNT(j)  (256  + 64 * (j))
#define XB_XSUB(j)  (1280 + 64 * (j))
#define XB_XGEN(j)  (2304 + 64 * (j))
#define XB_TOP      3328
#define XB_TOPGEN   3392
#define XCD_BAR_WORDS 3456
#define XB_SPIN_CAP (1u << 22)
DI unsigned xb_ld(unsigned* p) { return __hip_atomic_load(p, __ATOMIC_RELAXED, __HIP_MEMORY_SCOPE_AGENT); }
DI unsigned xb_add(unsigned* p, unsigned v) { return __hip_atomic_fetch_add(p, v, __ATOMIC_RELAXED, __HIP_MEMORY_SCOPE_AGENT); }
DI unsigned xb_xcc_id() { return (unsigned)__builtin_amdgcn_s_getreg((3 << 11) | 20) & 0xFu; }
#define XB_SPIN(cond, bar) do { unsigned _sp = 0; while (cond) { __builtin_amdgcn_s_sleep(1); \
    if ((++_sp & 255u) == 0u) { if (xb_ld(&(bar)[XB_TMO])) break; if (_sp > XB_SPIN_CAP) { atomicAdd(&(bar)[XB_TMO], 1u); break; } } } } while (0)
DI void xcd_barrier_complete(unsigned* bar, unsigned x, unsigned& nloc, unsigned& nx) {
  const unsigned G = gridDim.x;
  unsigned sum, cnt, mine, sp = 0u;
  for (;;) {
    sum = 0u; cnt = 0u; mine = 0u;
#pragma unroll
    for (unsigned j = 0; j < 16; ++j) { const unsigned c = xb_ld(&bar[XB_XCNT(j)]); sum += c; cnt += (c > 0u) ? 1u : 0u; mine = (j == x) ? c : mine; }
    if (sum == G) break;
    __builtin_amdgcn_s_sleep(1);
    if ((++sp & 255u) == 0u) { if (xb_ld(&bar[XB_TMO])) break; if (sp > XB_SPIN_CAP) { atomicAdd(&bar[XB_TMO], 1u); break; } }
  }
  nloc = mine > 0u ? mine : 1u; nx = cnt > 0u ? cnt : 1u;
}
#define LAS __attribute__((address_space(3)))
DI void xcd_barrier(unsigned* bar, unsigned x, volatile LAS unsigned* st) {
  asm volatile("s_waitcnt vmcnt(0)" ::: "memory");
  __syncthreads();
  if (threadIdx.x == 0) {
    __builtin_amdgcn_s_waitcnt(0);
    unsigned nloc = st[0], nx = st[1];
    if (nloc == 0u) { xcd_barrier_complete(bar, x, nloc, nx); st[0] = nloc; st[1] = nx; }
    const unsigned old = xb_add(&bar[XB_XSUB(x)], 1u);
    const unsigned gen = old / nloc;
    if (old + 1u == (gen + 1u) * nloc) {
      __builtin_amdgcn_fence(__ATOMIC_RELEASE, "agent");
      asm volatile("s_waitcnt vmcnt(0)" ::: "memory");
      const unsigned og = xb_add(&bar[XB_TOP], 1u);
      const unsigned tg = og / nx;
      if (og + 1u == (tg + 1u) * nx) xb_add(&bar[XB_TOPGEN], 1u);
      else XB_SPIN(xb_ld(&bar[XB_TOPGEN]) == tg, bar);
      __builtin_amdgcn_fence(__ATOMIC_ACQUIRE, "agent");
      xb_add(&bar[XB_XGEN(x)], 1u);
      asm volatile("s_waitcnt vmcnt(0)" ::: "memory");
    } else {
      XB_SPIN(xb_ld(&bar[XB_XGEN(x)]) == gen, bar);
      __builtin_amdgcn_fence(__ATOMIC_ACQUIRE, "agent");
      asm volatile("s_waitcnt vmcnt(0)" ::: "memory");
    }
  }
  __syncthreads();
}

__device__ void run_phase(const Params& p, int ph, bf16_t* lds) {
  if (ph == 0) { phase_prep(p, lds); return; }
  if (ph == NPHASE - 1) { phase_ln(p, 16384, 32768); return; }
  const int c = (ph - 1) / 4, sub = (ph - 1) % 4, row0 = c ? 16384 : 0, nrows = c ? 32768 : 16384, S = c ? 4096 : 16384;
  const int lgmx = c ? 4 : 3, MX = 1 << lgmx, MT = 8 * MX;
  if (sub == 0) {
    const bf16_t* X = p.xb + (size_t)row0 * PX;
    for (int id = BID; id < 34 * MT; id += gridDim.x) {
      const int xcd = id & 7, j = id >> 3, n = j >> lgmx, m = MX * xcd + (j & (MX - 1));
      gemm_tile<EPI_INPROJ>(p, p.WinT, X, n, m, row0, S, lds);
    }
    if (c > 0) phase_ln(p, 0, 16384);
    else {
      const int G = gridDim.x, rem = (34 * MT) % G, b = BID;
      if (rem == 0) convert_x(p, 16384, T_ALL, b, G);
      else if (b >= rem) convert_x(p, 16384, T_ALL, b - rem, G - rem);
    }
  } else if (sub == 1) {
    const int nunits = nrows >> 5, UX = nunits >> 3;
    const bool conv_first = ((BID >> 3) & 1) != 0;
    if (conv_first) phase_conv(p, S, nrows);
    for (int id = BID; id < nunits; id += gridDim.x) attn_unit(p, S, UX * (id & 7) + (id >> 3), lds);
    if (!conv_first) phase_conv(p, S, nrows);
  } else if (sub == 2) {
    for (int id = BID; id < 4 * MT; id += gridDim.x) { const int j = id >> 3; gemm_tile<EPI_AOUT>(p, p.WaT, p.Q, j & 3, MX * (id & 7) + (j >> 2), row0, S, lds); }
  } else {
    for (int id = BID; id < 4 * MT; id += gridDim.x) { const int j = id >> 3; gemm_tile<EPI_OUT>(p, p.WoT, p.G, j & 3, MX * (id & 7) + (j >> 2), row0, S, lds); }
  }
}

__global__ void __launch_bounds__(NTHR, 2) mega(Params p, int ph_begin, int ph_end) {
  __shared__ __attribute__((aligned(16))) bf16_t lds[LDS_ELEMS];
  __shared__ uint4 xb_words;
  if (threadIdx.x == 0) xb_words = make_uint4(0u, 0u, 0u, 0u);
  __syncthreads();
  const unsigned xcc = xb_xcc_id();
  if (threadIdx.x == 0 && ph_end - ph_begin > 1) (void)xb_add(&p.bar[XB_XCNT(xcc)], 1u);
  if (ph_begin < 0) cg::this_grid().sync();
  for (int ph = ph_begin; ph < ph_end; ++ph) {
    run_phase(p, ph, lds);
    if (ph + 1 < ph_end) xcd_barrier(p.bar, xcc, (volatile LAS unsigned*)&xb_words);
  }
}

extern "C" void kernel_launch(void* const* d_in, const int* in_sizes, int n_in, void* d_out, int out_size, void* d_ws, size_t ws_size, hipStream_t stream) {
  static int grid_blocks = 0;
  if (!grid_blocks) {
    int dev = 0, cus = 0, per_cu = 0;
    hipGetDevice(&dev);
    hipDeviceGetAttribute(&cus, hipDeviceAttributeMultiprocessorCount, dev);
    hipOccupancyMaxActiveBlocksPerMultiprocessor(&per_cu, mega, NTHR, 0);
    if (per_cu > 1) per_cu = 1;
    if (per_cu < 1) per_cu = 1;
    if (per_cu > 4) per_cu = 4;
    grid_blocks = cus * per_cu;
  }
  Params p{};
  p.xp = (const float*)d_in[0]; p.xs = (const float*)d_in[1]; p.w_in = (const float*)d_in[2]; p.b_in = (const float*)d_in[3];
  p.q_gain = (const float*)d_in[4]; p.k_gain = (const float*)d_in[5]; p.conv_w = (const float*)d_in[6]; p.conv_b = (const float*)d_in[7];
  p.w_attn_out = (const float*)d_in[8]; p.w_conv_out = (const float*)d_in[9]; p.w_o = (const float*)d_in[10];
  p.ln_g = (const float*)d_in[11]; p.ln_b = (const float*)d_in[12];
  p.out = (float*)d_out;
  char* w = (char*)d_ws; size_t off = 0;
  auto take = [&](size_t bytes) { char* q = w + off; off += (bytes + 255) & ~(size_t)255; return q; };
  p.WinT = (bf16_t*)take((size_t)INW * PX * 2);
  p.WaT = (bf16_t*)take((size_t)D * D * 2); p.WcT = (bf16_t*)take((size_t)D * D * 2); p.WoT = (bf16_t*)take((size_t)D * D * 2);
  p.bias_v = (float*)take(INW * 4); p.tab_cos = (float*)take(256 * 16 * 4); p.tab_sin = (float*)take(256 * 16 * 4);
  p.xb = (bf16_t*)take((size_t)T_ALL * PX * 2);
  p.Q = (bf16_t*)take((size_t)CHMAX * D * 2); p.Kb = (bf16_t*)take((size_t)CHMAX * 256 * 2); p.Vt = (bf16_t*)take((size_t)CHMAX * 256 * 2);
  p.sza = (bf16_t*)take((size_t)CHMAX * D * 2); p.U = (bf16_t*)take((size_t)CHMAX * D * 2); p.G = (bf16_t*)take((size_t)CHMAX * D * 2);
  p.sga = (bf16_t*)take((size_t)CHMAX * D * 2); p.sgc = (bf16_t*)take((size_t)CHMAX * D * 2); p.conv = (bf16_t*)take((size_t)CHMAX * D * 2);
  p.mc = p.sgc;
  p.bar = (unsigned*)take(XCD_BAR_WORDS * 4);
  if (off > ws_size) { fprintf(stderr, "workspace too small: need %zu have %zu\n", off, ws_size); return; }
#if MK_SINGLE
  hipMemsetAsync(p.bar, 0, XCD_BAR_WORDS * 4, stream);
  int b = 0, e = NPHASE;
  void* args[] = {&p, &b, &e};
  hipError_t err = hipLaunchCooperativeKernel((void*)mega, dim3(grid_blocks), dim3(NTHR), args, 0, stream);
  if (err != hipSuccess) fprintf(stderr, "cooperative launch failed: %s (grid %d)\n", hipGetErrorString(err), grid_blocks);
#else
  for (int ph = 0; ph < NPHASE; ++ph) hipLaunchKernelGGL(mega, dim3(grid_blocks), dim3(NTHR), 0, stream, p, ph, ph + 1);
#endif
}
```
